# Optimizing an MI355X kernel written in HIP

```python
import math
import jax, jax.numpy as jnp
from jax import lax
import numpy as np

D_MODEL = 1024
BATCH = 4
SEQ = 4096
DEPTH = 4

CHUNK = 64
N_A_LAYERS = DEPTH // 2
N_B_LAYERS = DEPTH - N_A_LAYERS
POOL_WINDOWS = (2, 4, 8, 16)
N_POOL_GROUPS = len(POOL_WINDOWS)
POOL_GROUP_DIM = D_MODEL // N_POOL_GROUPS
D_FF = -(-8 * D_MODEL // (3 * 256)) * 256
N_HEADS = 8
QK_NOPE_DIM = 128
QK_ROPE_DIM = 64
QK_HEAD_DIM = QK_NOPE_DIM + QK_ROPE_DIM
V_HEAD_DIM = 128
Q_LORA_RANK = 256
KV_LORA_RANK = 512
ROPE_THETA = 10000.0
Q_BLOCK = 128
EPS = 1e-6

kernel_name = "yoco_pool_mla_hybrid"


def rms_norm(x, g):
    xf = x.astype(jnp.float32)
    y = xf * lax.rsqrt(jnp.mean(xf * xf, axis=-1, keepdims=True) + EPS)
    return (y * g.astype(jnp.float32)).astype(x.dtype)


def swiglu(h, w_gate, w_up, w_down):
    return (jax.nn.silu(h @ w_gate) * (h @ w_up)) @ w_down


def pool_mix(h, w_pool, b_pool, scale):
    B, S, D = h.shape
    hf = h.astype(jnp.float32)
    cs0 = jnp.pad(jnp.cumsum(hf, axis=1), ((0, 0), (1, 0), (0, 0)))
    t1 = jnp.arange(1, S + 1)
    groups = []
    for g, w in enumerate(POOL_WINDOWS):
        sl = slice(g * POOL_GROUP_DIM, (g + 1) * POOL_GROUP_DIM)
        c = cs0[:, :, sl]
        lag = jnp.pad(c, ((0, 0), (w, 0), (0, 0)))[:, : S + 1]
        win = (c - lag)[:, 1:]
        cnt = jnp.minimum(t1, w).astype(jnp.float32)[None, :, None]
        groups.append(win / cnt - hf[:, :, sl])
    d = jnp.stack(groups, axis=2).astype(h.dtype)
    y = jnp.einsum('bsgc,gcd->bsgd', d, w_pool) + b_pool
    return y.reshape(B, S, D) * scale


def rope(x, positions):
    R = x.shape[-1]
    half = R // 2
    inv = ROPE_THETA ** (-jnp.arange(half, dtype=jnp.float32) * 2.0 / R)
    ang = positions.astype(jnp.float32)[..., None] * inv
    cos = jnp.cos(ang)[:, :, None, :]
    sin = jnp.sin(ang)[:, :, None, :]
    xf = x.astype(jnp.float32)
    x1, x2 = xf[..., :half], xf[..., half:]
    return jnp.concatenate([x1 * cos - x2 * sin, x2 * cos + x1 * sin], axis=-1).astype(x.dtype)


def shared_kv(h, positions, w_dkv, g_kv_latent, w_uk, w_uv, g_k):
    B, S, _ = h.shape
    ckv = h @ w_dkv
    c = rms_norm(ckv[..., :KV_LORA_RANK], g_kv_latent)
    k_pe = ckv[..., KV_LORA_RANK:]
    k_nope = (c @ w_uk).reshape(B, S, N_HEADS, QK_NOPE_DIM)
    v = (c @ w_uv).reshape(B, S, N_HEADS, V_HEAD_DIM)
    k = jnp.concatenate([k_nope, jnp.broadcast_to(k_pe[:, :, None, :], (B, S, N_HEADS, QK_ROPE_DIM))], axis=-1)
    k = rms_norm(k, g_k)
    k = jnp.concatenate([k[..., :QK_NOPE_DIM], rope(k[..., QK_NOPE_DIM:], positions)], axis=-1)
    return k, v


def mla_queries(h, positions, w_dq, g_q_latent, w_uq, g_q):
    B, S, _ = h.shape
    cq = rms_norm(h @ w_dq, g_q_latent)
    q = (cq @ w_uq).reshape(B, S, N_HEADS, QK_HEAD_DIM)
    q = rms_norm(q, g_q)
    return jnp.concatenate([q[..., :QK_NOPE_DIM], rope(q[..., QK_NOPE_DIM:], positions)], axis=-1)


def chunk_causal_attention(q, k, v):
    S = q.shape[1]
    scale = 1.0 / math.sqrt(QK_HEAD_DIM)
    outs = []
    for i in range(S // Q_BLOCK):
        start, end = i * Q_BLOCK, (i + 1) * Q_BLOCK
        s = jnp.einsum('bqhd,bkhd->bhqk', q[:, start:end], k[:, :end]).astype(jnp.float32) * scale
        qc = (start + jnp.arange(Q_BLOCK)) // CHUNK
        kc = jnp.arange(end) // CHUNK
        mask = kc[None, :] <= qc[:, None]
        s = jnp.where(mask[None, None], s, jnp.float32(-1e30))
        p = jax.nn.softmax(s, axis=-1).astype(v.dtype)
        outs.append(jnp.einsum('bhqk,bkhd->bqhd', p, v[:, :end]))
    return jnp.concatenate(outs, axis=1)


def setup_inputs(seed: int = 0) -> dict:
    key = jax.random.key(seed)
    ks = iter(jax.random.split(key, 32))
    f32 = jnp.float32

    def w(shape, fan_in):
        return jax.random.normal(next(ks), shape, f32) * fan_in ** -0.5

    def gain(shape):
        return 1.0 + 0.02 * jax.random.normal(next(ks), shape, f32)

    x = jax.random.normal(next(ks), (BATCH, SEQ, D_MODEL), f32)
    positions = jnp.broadcast_to(jnp.arange(SEQ, dtype=jnp.int32)[None, :], (BATCH, SEQ)).astype(jnp.int32)
    return {
        "x": x,
        "positions": positions,
        "ln_mix_a": gain((N_A_LAYERS, D_MODEL)),
        "w_pool": w((N_A_LAYERS, N_POOL_GROUPS, POOL_GROUP_DIM, POOL_GROUP_DIM), POOL_GROUP_DIM),
        "b_pool": 0.02 * jax.random.normal(next(ks), (N_A_LAYERS, N_POOL_GROUPS, POOL_GROUP_DIM), f32),
        "pool_scale": gain((N_A_LAYERS, D_MODEL)),
        "ln_ffn": gain((DEPTH, D_MODEL)),
        "w_gate": w((DEPTH, D_MODEL, D_FF), D_MODEL),
        "w_up": w((DEPTH, D_MODEL, D_FF), D_MODEL),
        "w_down": w((DEPTH, D_FF, D_MODEL), D_FF),
        "ln_kv": gain((D_MODEL,)),
        "w_dkv": w((D_MODEL, KV_LORA_RANK + QK_ROPE_DIM), D_MODEL),
        "g_kv_latent": gain((KV_LORA_RANK,)),
        "w_uk": w((KV_LORA_RANK, N_HEADS * QK_NOPE_DIM), KV_LORA_RANK),
        "w_uv": w((KV_LORA_RANK, N_HEADS * V_HEAD_DIM), KV_LORA_RANK),
        "g_k": gain((QK_HEAD_DIM,)),
        "ln_mix_b": gain((N_B_LAYERS, D_MODEL)),
        "w_dq": w((N_B_LAYERS, D_MODEL, Q_LORA_RANK), D_MODEL),
        "g_q_latent": gain((N_B_LAYERS, Q_LORA_RANK)),
        "w_uq": w((N_B_LAYERS, Q_LORA_RANK, N_HEADS * QK_HEAD_DIM), Q_LORA_RANK),
        "g_q": gain((N_B_LAYERS, QK_HEAD_DIM)),
        "w_o": w((N_B_LAYERS, N_HEADS * V_HEAD_DIM, D_MODEL), N_HEADS * V_HEAD_DIM),
    }


def reference(x, positions, ln_mix_a, w_pool, b_pool, pool_scale, ln_ffn, w_gate, w_up, w_down,
              ln_kv, w_dkv, g_kv_latent, w_uk, w_uv, g_k,
              ln_mix_b, w_dq, g_q_latent, w_uq, g_q, w_o):
    B, S, D = x.shape
    k_sh, v_sh = None, None
    for l in range(DEPTH):
        if l < N_A_LAYERS:
            x = x + pool_mix(rms_norm(x, ln_mix_a[l]), w_pool[l], b_pool[l], pool_scale[l])
        else:
            j = l - N_A_LAYERS
            q = mla_queries(rms_norm(x, ln_mix_b[j]), positions, w_dq[j], g_q_latent[j], w_uq[j], g_q[j])
            o = chunk_causal_attention(q, k_sh, v_sh)
            x = x + o.reshape(B, S, N_HEADS * V_HEAD_DIM) @ w_o[j]
        x = x + swiglu(rms_norm(x, ln_ffn[l]), w_gate[l], w_up[l], w_down[l])
        if l == N_A_LAYERS - 1:
            k_sh, v_sh = shared_kv(rms_norm(x, ln_kv), positions, w_dkv, g_kv_latent, w_uk, w_uv, g_k)
    return x
```

```cpp
#define GEMM_MODE 1
#define ONE_LAUNCH 1
#include <hip/hip_runtime.h>
#include <cstdio>
#include <cstdint>

#define LAS __attribute__((address_space(3)))
#define GAS __attribute__((address_space(1)))
typedef unsigned short bf16_t;
typedef short bf16x8 __attribute__((ext_vector_type(8)));
typedef float f32x4 __attribute__((ext_vector_type(4)));
typedef float f32x16 __attribute__((ext_vector_type(16)));
typedef unsigned u32x4 __attribute__((ext_vector_type(4)));
typedef unsigned u32x2 __attribute__((ext_vector_type(2)));

constexpr int BATCH = 4, SEQ = 4096, DM = 1024, M = BATCH * SEQ, DFF = 2816, NH = 8, DN = 128, DR = 64, DQK = 192, DV = 128, QLR = 256, KVLR = 512;
constexpr int NGU = 2 * DFF;
constexpr float EPS = 1e-6f;
constexpr float QSCALE = 0.07216878364870322f * 1.4426950408889634f;

__device__ __forceinline__ unsigned cvt_pk_bf16(float lo, float hi) { unsigned r; asm volatile("v_cvt_pk_bf16_f32 %0, %1, %2" : "=v"(r) : "v"(lo), "v"(hi)); return r; }
__device__ __forceinline__ u32x4 pack8(f32x4 a, f32x4 b) { u32x4 w; w.x = cvt_pk_bf16(a[0], a[1]); w.y = cvt_pk_bf16(a[2], a[3]); w.z = cvt_pk_bf16(b[0], b[1]); w.w = cvt_pk_bf16(b[2], b[3]); return w; }
__device__ __forceinline__ float bf2f(unsigned v) { return __uint_as_float(v << 16); }
__device__ __forceinline__ float bflo(unsigned w) { return __uint_as_float(w << 16); }
__device__ __forceinline__ float bfhi(unsigned w) { return __uint_as_float(w & 0xffff0000u); }
__device__ __forceinline__ float wave_sum(float v) {
#pragma unroll
    for (int o = 1; o < 64; o <<= 1) v += __shfl_xor(v, o);
    return v;
}
__device__ __forceinline__ float row_rinv(const float* stat, int row, float invn) { const f32x4 p = *(const f32x4*)(stat + 4 * (size_t)row); return rsqrtf(((p.x + p.y) + (p.z + p.w)) * invn + EPS); }

namespace pg8 {
constexpr int BM = 256, BK = 64, HALF = 128, HTB = HALF * BK * 2  , STAGE_BYTES = 8 * HTB, NXCD = 8, WGM = 8;
__host__ __device__ __forceinline__ int lds_byte(int r, int c) { const int st = (r >> 4) * 2 + (c >> 5), rr = r & 15, cc = c & 31, ob = rr * 64 + cc * 2; return st * 1024 + (ob ^ (((ob >> 9) & 1) << 5)); }
__host__ __device__ __forceinline__ void stage_rc(int b, int& R, int& C) { const int st = b / 1024, sb = b % 1024, swz = sb ^ (((sb >> 9) & 1) << 5); R = (st >> 1) * 16 + swz / 64; C = (st & 1) * 32 + (swz % 64) / 2; }
__host__ __device__ __forceinline__ int perm32(int rho) { const int n = rho >> 4, i = rho & 15; return 8 * (i >> 2) + 4 * n + (i & 3); }

struct Unit { int pm, pn; };
struct Gemm { const bf16_t* A; const bf16_t* Bt; int M, N, K, lda, ldb, a_pn_stride; };

struct StaticOrder {
    int nM, nN, nwg, G, c;
    __host__ __device__ void init(int M, int N, int G_, int c_) { nM = M / BM; nN = N / BM; nwg = nM * nN; G = G_; c = c_; }
    __host__ __device__ bool next(int i, Unit& u) const {
        const long L = (long)i * G + c; if (L >= nwg) return false;
        int wgid = (int)L; { const int q = nwg / NXCD, r = nwg % NXCD, xcd = wgid % NXCD, off = wgid / NXCD; wgid = (xcd < r ? xcd * (q + 1) : r * (q + 1) + (xcd - r) * q) + off; }
        const int nig = WGM * nN, gid = wgid / nig, fm = gid * WGM, gsz = (nM - fm) < WGM ? (nM - fm) : WGM;
        u.pm = fm + ((wgid % nig) % gsz); u.pn = (wgid % nig) / gsz; return true;
    }
    __device__ __forceinline__ void a_ready(const Unit&) const {}
    __device__ __forceinline__ void done(const Unit&) const {}
};

template <class Q> struct EpiQuad {
    static constexpr bool PERM = true, AFTER_DRAIN = false;
    Q q;
    __device__ __forceinline__ void operator()(const f32x4 (&acc)[2][2][4][2], const Unit& u, int wr, int wc, int fr, int fq) const {
        const int cin = wc * 32 + 8 * fq;
#pragma unroll
        for (int ai = 0; ai < 2; ++ai)
#pragma unroll
            for (int m = 0; m < 4; ++m) {
                const int row = u.pm * BM + ai * HALF + wr * 64 + m * 16 + fr;
                q.quad(row, u.pn, cin, acc[ai][0][m][0], acc[ai][0][m][1], acc[ai][1][m][0], acc[ai][1][m][1]);
            }
    }
};

template <class Epi, class Sched, bool ALIGN_EPI = false, bool SP2 = false>
__device__ __forceinline__ void gemm_phase(LAS unsigned char* lds, const Gemm g, const Sched& S, const Epi& E, const int tid) {
    const int wid = __builtin_amdgcn_readfirstlane(tid >> 6), lane = tid & 63, wr = wid >> 2, wc = wid & 3, fr = lane & 15, fq = lane >> 4;
    const int K = g.K, nt = K / BK;
    unsigned voffA[2], voffB[2];
#pragma unroll
    for (int i = 0; i < 2; ++i) { int R, C; stage_rc(tid * 16 + i * 8192, R, C); const int Rb = Epi::PERM ? ((R & ~31) + perm32(R & 31)) : R;
        voffA[i] = (unsigned)(R * g.lda + C) * 2u; voffB[i] = (unsigned)(Rb * g.ldb + C) * 2u; }
    const size_t kstep = (size_t)(BK * 2);
    const size_t hstepA = (size_t)HALF * g.lda * 2, hstepB = (size_t)HALF * g.ldb * 2;
    const size_t tstepA = 2 * hstepA, tstepB = 2 * hstepB;
    const size_t pnA = (size_t)g.a_pn_stride * 2;
    const unsigned ldsw = (unsigned)wid * 1024u;
    const int aoff = lds_byte(wr * 64 + fr, fq * 8), boff = lds_byte(wc * 32 + fr, fq * 8);
#define PG8_SA(b, h) (((b) * 2 + (h)) * HTB)
#define PG8_SB(b, h) ((4 + (b) * 2 + (h)) * HTB)
#define PG8_STAGE(bufoff, gbase, voff) do { _Pragma("unroll") for (int _i = 0; _i < 2; ++_i) \
        __builtin_amdgcn_global_load_lds((const unsigned*)((const char*)(gbase) + (voff)[_i]), (LAS unsigned*)(lds + (bufoff) + ldsw + _i * 8192), 16, 0, 0); } while (0)
#define PG8_LDA(dst, b, h) do { _Pragma("unroll") for (int m = 0; m < 4; ++m) _Pragma("unroll") for (int k = 0; k < 2; ++k) dst[m][k] = *(const LAS bf16x8*)(lds + PG8_SA(b, h) + aoff + m * 2048 + k * 1024); } while (0)
#define PG8_LDB(dst, b, h) do { _Pragma("unroll") for (int n = 0; n < 2; ++n) _Pragma("unroll") for (int k = 0; k < 2; ++k) dst[n][k] = *(const LAS bf16x8*)(lds + PG8_SB(b, h) + boff + n * 2048 + k * 1024); } while (0)
#define PG8_MMA(ai, bj, At, Bt) do { __builtin_amdgcn_s_setprio(1); _Pragma("unroll") for (int m = 0; m < 4; ++m) _Pragma("unroll") for (int n = 0; n < 2; ++n) _Pragma("unroll") for (int k = 0; k < 2; ++k) \
        acc[ai][bj][m][n] = __builtin_amdgcn_mfma_f32_16x16x32_bf16(Bt[n][k], At[m][k], acc[ai][bj][m][n], 0, 0, 0); __builtin_amdgcn_s_setprio(0); } while (0)
#define PG8_WAIT_V(n) asm volatile("s_waitcnt vmcnt(" #n ")" ::: "memory")
#define PG8_WAIT_L(n) asm volatile("s_waitcnt lgkmcnt(" #n ")" ::: "memory")
#define PG8_BAR __builtin_amdgcn_s_barrier()
#define PG8_SCHED __builtin_amdgcn_sched_barrier(0)
    Unit cur, nxt; int ui = 0;
    if (!S.next(0, cur)) return;
    f32x4 acc[2][2][4][2];
#pragma unroll
    for (int a = 0; a < 2; ++a)
#pragma unroll
        for (int b = 0; b < 2; ++b)
#pragma unroll
            for (int m = 0; m < 4; ++m)
#pragma unroll
                for (int n = 0; n < 2; ++n) acc[a][b][m][n] = (f32x4){0.f, 0.f, 0.f, 0.f};
    bf16x8 At[4][2], B0[2][2], B1[2][2];
    const char* cA = (const char*)g.A + (size_t)cur.pm * tstepA + (size_t)cur.pn * pnA; const char* cB = (const char*)g.Bt + (size_t)cur.pn * tstepB;
    S.a_ready(cur);
    if constexpr (SP2) {
        PG8_STAGE(PG8_SB(0, 0), cB, voffB); PG8_STAGE(PG8_SB(0, 1), cB + hstepB, voffB); PG8_STAGE(PG8_SA(0, 0), cA, voffA); PG8_STAGE(PG8_SA(0, 1), cA + hstepA, voffA);
        if (wr == 1) PG8_BAR;
        PG8_WAIT_V(2); PG8_BAR;
        PG8_STAGE(PG8_SB(1, 0), cB + kstep, voffB); PG8_STAGE(PG8_SA(1, 0), cA + kstep, voffA); PG8_STAGE(PG8_SB(1, 1), cB + hstepB + kstep, voffB);
        PG8_WAIT_V(6); PG8_BAR;
    } else {
        PG8_STAGE(PG8_SB(0, 0), cB, voffB); PG8_STAGE(PG8_SA(0, 0), cA, voffA); PG8_STAGE(PG8_SB(0, 1), cB + hstepB, voffB); PG8_STAGE(PG8_SA(0, 1), cA + hstepA, voffA);
        if (wr == 1) PG8_BAR;
        PG8_WAIT_V(4); PG8_BAR;
        PG8_STAGE(PG8_SB(1, 0), cB + kstep, voffB); PG8_STAGE(PG8_SA(1, 0), cA + kstep, voffA); PG8_STAGE(PG8_SB(1, 1), cB + hstepB + kstep, voffB);
        PG8_WAIT_V(6); PG8_BAR;
    }
    for (;;) {
        const bool has_next = S.next(ui + 1, nxt);
        const char* nA = has_next ? (const char*)g.A + (size_t)nxt.pm * tstepA + (size_t)nxt.pn * pnA : cA; const char* nB = has_next ? (const char*)g.Bt + (size_t)nxt.pn * tstepB : cB;
        for (int t = 0; t < nt; t += 2) {
            const bool last = (t == nt - 2);
            const char* a1 = cA + (size_t)(t + 1) * kstep;
            const char* a2 = last ? nA : cA + (size_t)(t + 2) * kstep; const char* b2 = last ? nB : cB + (size_t)(t + 2) * kstep;
            const char* a3 = a2 + kstep; const char* b3 = b2 + kstep;
            if (last && has_next) S.a_ready(nxt);
            if constexpr (SP2) {
            PG8_LDB(B0, 0, 0); PG8_LDB(B1, 0, 1); PG8_SCHED; PG8_LDA(At, 0, 0); PG8_STAGE(PG8_SA(1, 1), a1 + hstepA, voffA);
            PG8_WAIT_V(8); PG8_WAIT_L(0); PG8_BAR; PG8_MMA(0, 0, At, B0); PG8_MMA(0, 1, At, B1); PG8_BAR; PG8_SCHED;
            PG8_LDA(At, 0, 1); PG8_STAGE(PG8_SB(0, 0), b2, voffB); PG8_STAGE(PG8_SB(0, 1), b2 + hstepB, voffB); PG8_STAGE(PG8_SA(0, 0), a2, voffA);
            PG8_WAIT_V(8); PG8_WAIT_L(0); PG8_BAR; PG8_MMA(1, 0, At, B0); PG8_MMA(1, 1, At, B1); PG8_BAR; PG8_SCHED;
            PG8_LDB(B0, 1, 0); PG8_LDB(B1, 1, 1); PG8_SCHED; PG8_LDA(At, 1, 0); PG8_STAGE(PG8_SA(0, 1), a2 + hstepA, voffA);
            PG8_WAIT_V(8); PG8_WAIT_L(0); PG8_BAR; PG8_MMA(0, 0, At, B0); PG8_MMA(0, 1, At, B1); PG8_BAR; PG8_SCHED;
            PG8_LDA(At, 1, 1); PG8_STAGE(PG8_SB(1, 0), b3, voffB); PG8_STAGE(PG8_SB(1, 1), b3 + hstepB, voffB); PG8_STAGE(PG8_SA(1, 0), a3, voffA);
            PG8_WAIT_V(8); PG8_WAIT_L(0); PG8_BAR; PG8_MMA(1, 0, At, B0); PG8_MMA(1, 1, At, B1); PG8_BAR; PG8_SCHED;
            } else {
            PG8_LDB(B0, 0, 0); PG8_SCHED; PG8_LDA(At, 0, 0); PG8_STAGE(PG8_SA(1, 1), a1 + hstepA, voffA);
            PG8_WAIT_L(8); PG8_BAR; PG8_WAIT_L(0); PG8_MMA(0, 0, At, B0); PG8_BAR; PG8_SCHED;
            PG8_LDB(B1, 0, 1); PG8_STAGE(PG8_SB(0, 0), b2, voffB);
            PG8_BAR; PG8_WAIT_L(0); PG8_MMA(0, 1, At, B1); PG8_BAR;
            PG8_LDA(At, 0, 1); PG8_STAGE(PG8_SA(0, 0), a2, voffA);
            PG8_BAR; PG8_WAIT_L(0); PG8_MMA(1, 0, At, B0); PG8_BAR; PG8_SCHED;
            PG8_STAGE(PG8_SB(0, 1), b2 + hstepB, voffB);
            PG8_WAIT_V(6); PG8_BAR; PG8_MMA(1, 1, At, B1); PG8_BAR;
            PG8_LDB(B0, 1, 0); PG8_SCHED; PG8_LDA(At, 1, 0); PG8_STAGE(PG8_SA(0, 1), a2 + hstepA, voffA);
            PG8_WAIT_L(8); PG8_BAR; PG8_WAIT_L(0); PG8_MMA(0, 0, At, B0); PG8_BAR; PG8_SCHED;
            PG8_LDB(B1, 1, 1); PG8_STAGE(PG8_SB(1, 0), b3, voffB);
            PG8_BAR; PG8_WAIT_L(0); PG8_MMA(0, 1, At, B1); PG8_BAR;
            PG8_LDA(At, 1, 1); PG8_STAGE(PG8_SA(1, 0), a3, voffA);
            PG8_BAR; PG8_WAIT_L(0); PG8_MMA(1, 0, At, B0); PG8_BAR; PG8_SCHED;
            PG8_STAGE(PG8_SB(1, 1), b3 + hstepB, voffB);
            PG8_WAIT_V(6); PG8_BAR; PG8_MMA(1, 1, At, B1); PG8_BAR;
            }
        }
        if constexpr (ALIGN_EPI) { if (wr == 0) PG8_BAR; }
        if constexpr (!Epi::AFTER_DRAIN) { E(acc, cur, wr, wc, fr, fq); S.done(cur); }
        if (!has_next) break;
#pragma unroll
        for (int a = 0; a < 2; ++a)
#pragma unroll
            for (int b = 0; b < 2; ++b)
#pragma unroll
                for (int m = 0; m < 4; ++m)
#pragma unroll
                    for (int n = 0; n < 2; ++n) acc[a][b][m][n] = (f32x4){0.f, 0.f, 0.f, 0.f};
        cur = nxt; cA = nA; cB = nB; ++ui;
        if constexpr (ALIGN_EPI) { if (wr == 1) PG8_BAR; }
    }
    PG8_WAIT_V(0);
    if constexpr (!ALIGN_EPI) { if (wr == 0) PG8_BAR; }
    PG8_BAR;
    if constexpr (Epi::AFTER_DRAIN) { E.fused(acc, cur, wr, wc, fr, fq, lds, wid, lane); S.done(cur); }
#undef PG8_SA
#undef PG8_SB
#undef PG8_STAGE
#undef PG8_LDA
#undef PG8_LDB
#undef PG8_MMA
#undef PG8_WAIT_V
#undef PG8_WAIT_L
#undef PG8_BAR
#undef PG8_SCHED
}

template <class Q>
__device__ __forceinline__ void gemm_simple(const Gemm g, const Q& q, int gw, int ngw, const int lane_) {
    const int lane = lane_, fr = lane & 15, fq = lane >> 4;
    const int nN = g.N / BM, nunits = (g.M / BM) * nN, K = g.K;
    for (int wt = gw; wt < nunits * 32; wt += ngw) {
        const int u = wt >> 5, rb = (wt & 31) >> 2, wc = wt & 3, pm = u / nN, pn = u % nN, row0 = pm * BM + rb * 32;
        f32x4 acc[2][2][2];
#pragma unroll
        for (int m = 0; m < 2; ++m)
#pragma unroll
            for (int bj = 0; bj < 2; ++bj)
#pragma unroll
                for (int n = 0; n < 2; ++n) acc[m][bj][n] = (f32x4){0.f, 0.f, 0.f, 0.f};
        const bf16_t* ap[2]; const bf16_t* bp[2][2];
#pragma unroll
        for (int m = 0; m < 2; ++m) ap[m] = g.A + (size_t)(row0 + 16 * m + fr) * g.lda + (size_t)pn * g.a_pn_stride + 8 * fq;
#pragma unroll
        for (int bj = 0; bj < 2; ++bj)
#pragma unroll
            for (int n = 0; n < 2; ++n) bp[bj][n] = g.Bt + (size_t)(pn * BM + bj * HALF + wc * 32 + perm32(16 * n + fr)) * g.ldb + 8 * fq;
        for (int k0 = 0; k0 < K; k0 += 32) {
            bf16x8 a[2], b[2][2];
#pragma unroll
            for (int m = 0; m < 2; ++m) a[m] = *(const bf16x8*)(ap[m] + k0);
#pragma unroll
            for (int bj = 0; bj < 2; ++bj)
#pragma unroll
                for (int n = 0; n < 2; ++n) b[bj][n] = *(const bf16x8*)(bp[bj][n] + k0);
#pragma unroll
            for (int m = 0; m < 2; ++m)
#pragma unroll
                for (int bj = 0; bj < 2; ++bj)
#pragma unroll
                    for (int n = 0; n < 2; ++n) acc[m][bj][n] = __builtin_amdgcn_mfma_f32_16x16x32_bf16(b[bj][n], a[m], acc[m][bj][n], 0, 0, 0);
        }
#pragma unroll
        for (int m = 0; m < 2; ++m) q.quad(row0 + 16 * m + fr, pn, wc * 32 + 8 * fq, acc[m][0][0], acc[m][0][1], acc[m][1][0], acc[m][1][1]);
    }
}
}

struct QResidual {
    const float* xin; float* xout; bf16_t* xb; const float* bias; const float* scale;
    __device__ __forceinline__ void half(int row, int col, f32x4 v0, f32x4 v1) const {
        const size_t off = (size_t)row * DM + col;
        if (bias) {
            const f32x4 b0 = *(const f32x4*)(bias + col), b1 = *(const f32x4*)(bias + col + 4), s0 = *(const f32x4*)(scale + col), s1 = *(const f32x4*)(scale + col + 4);
            v0 = (v0 + b0) * s0; v1 = (v1 + b1) * s1;
        }
        const f32x4 r0 = *(const f32x4*)(xin + off), r1 = *(const f32x4*)(xin + off + 4);
        v0 = v0 + r0; v1 = v1 + r1;
        *(f32x4*)(xout + off) = v0; *(f32x4*)(xout + off + 4) = v1;
        *(u32x4*)(xb + off) = pack8(v0, v1);
    }
    __device__ __forceinline__ void quad(int row, int pn, int cin, f32x4 a0, f32x4 a1, f32x4 b0, f32x4 b1) const {
        half(row, 256 * pn + cin, a0, a1); half(row, 256 * pn + 128 + cin, b0, b1);
    }
};
__device__ __forceinline__ float silu_mul(float g, float u) { return g * __builtin_amdgcn_rcpf(1.0f + __builtin_amdgcn_exp2f(-1.4426950408889634f * g)) * u; }
struct QGateUp {
    bf16_t* hid; const float* stat;
    __device__ __forceinline__ void quad(int row, int pn, int cin, f32x4 a0, f32x4 a1, f32x4 b0, f32x4 b1) const {
        const float r = row_rinv(stat, row, 1.0f / DM);
        f32x4 h0, h1;
#pragma unroll
        for (int i = 0; i < 4; ++i) { h0[i] = silu_mul(a0[i] * r, b0[i] * r); h1[i] = silu_mul(a1[i] * r, b1[i] * r); }
        *(u32x4*)(hid + (size_t)row * DFF + 128 * pn + cin) = pack8(h0, h1);
    }
};
struct QKvd {
    bf16_t* ckvb; bf16_t* cqb; float* kpe; const float* stat;
    __device__ __forceinline__ void quad(int row, int pn, int cin, f32x4 a0, f32x4 a1, f32x4 b0, f32x4 b1) const {
        const float r = row_rinv(stat, row, 1.0f / DM);
        a0 = a0 * r; a1 = a1 * r; b0 = b0 * r; b1 = b1 * r;
        if (pn < 2) { bf16_t* o = ckvb + (size_t)row * KVLR + 256 * pn + cin; *(u32x4*)o = pack8(a0, a1); *(u32x4*)(o + 128) = pack8(b0, b1); }
        else if (pn == 2) { bf16_t* o = cqb + (size_t)row * QLR + cin; *(u32x4*)o = pack8(a0, a1); *(u32x4*)(o + 128) = pack8(b0, b1); }
        else if (cin < DR) { float* o = kpe + (size_t)row * DR + cin; *(f32x4*)o = a0; *(f32x4*)(o + 4) = a1; }
    }
};
struct QRowScale {
    bf16_t* out; int ldc; const float* stat; float invn;
    __device__ __forceinline__ void quad(int row, int pn, int cin, f32x4 a0, f32x4 a1, f32x4 b0, f32x4 b1) const {
        const float r = row_rinv(stat, row, invn);
        bf16_t* o = out + (size_t)row * ldc + 256 * pn + cin;
        *(u32x4*)o = pack8(a0 * r, a1 * r); *(u32x4*)(o + 128) = pack8(b0 * r, b1 * r);
    }
};

constexpr int NWAVES = 8;
constexpr int RING_BYTES = 131072, MISC_OFF = RING_BYTES + 320, LDS_BYTES = 147456;
struct Frame {
    LAS unsigned char* lds; volatile LAS unsigned* MISC;
    int tid, lane, wave, vcu, G, gw, ngw;
};

enum { RM_PLAIN = 0, RM_GATE = 1, RM_UP = 2 };
__device__ __forceinline__ void prep_mat(const Frame& F, const float* W, int ldsrc, int K, int ncols, int col0, const float* gain, bf16_t* WT, int mode, int row0) {
    LAS float* scr = (LAS float*)(F.lds + F.wave * 16384);
    const int lane = F.lane, nblk = ncols / 32, nitems = (K / 64) * nblk;
    for (int item = F.gw; item < nitems; item += F.ngw) {
        const int kb = item / nblk, nb = item % nblk, k0 = 64 * kb, n0 = 32 * nb;
#pragma unroll 8
        for (int i = 0; i < 32; ++i) { const int kk = 2 * i + (lane >> 5); float v = W[(size_t)(k0 + kk) * ldsrc + col0 + n0 + (lane & 31)]; if (gain) v *= gain[k0 + kk]; scr[kk * 33 + (lane & 31)] = v; }
        asm volatile("s_waitcnt lgkmcnt(0)" ::: "memory");
        const int c = lane & 7;
#pragma unroll
        for (int j = 0; j < 4; ++j) { const int nl = (lane >> 3) + 8 * j, n = n0 + nl; const LAS float* s = scr + (8 * c) * 33 + nl;
            u32x4 o; o.x = cvt_pk_bf16(s[0 * 33], s[1 * 33]); o.y = cvt_pk_bf16(s[2 * 33], s[3 * 33]); o.z = cvt_pk_bf16(s[4 * 33], s[5 * 33]); o.w = cvt_pk_bf16(s[6 * 33], s[7 * 33]);
            const int drow = mode == RM_PLAIN ? row0 + n : (256 * (n >> 7) + (n & 127) + (mode == RM_UP ? 128 : 0));
            *(u32x4*)(WT + (size_t)drow * K + k0 + 8 * c) = o; }
        asm volatile("s_waitcnt lgkmcnt(0)" ::: "memory");
    }
}

__device__ __forceinline__ void rowstat_x(const Frame& F, const float* x, float* stat) {
    for (int r = F.gw; r < M; r += F.ngw) {
        const f32x4* p = (const f32x4*)(x + (size_t)r * DM) + F.lane; float s = 0.f;
#pragma unroll
        for (int j = 0; j < 4; ++j) { const f32x4 v = p[64 * j]; s += (v.x * v.x + v.y * v.y) + (v.z * v.z + v.w * v.w); }
        s = wave_sum(s);
        if (F.lane == 0) *(f32x4*)(stat + 4 * (size_t)r) = (f32x4){s, 0.f, 0.f, 0.f};
    }
}
__device__ __forceinline__ void rowstat_lat(const Frame& F, const bf16_t* ckvb, float* statc, const bf16_t* cqb, float* statq) {
    for (int r = F.gw; r < M; r += F.ngw) {
        if (ckvb) { const u32x4 w = *((const u32x4*)(ckvb + (size_t)r * KVLR) + F.lane); float s = 0.f;
#pragma unroll
            for (int i = 0; i < 4; ++i) { const float a = bflo(w[i]), b = bfhi(w[i]); s += a * a + b * b; }
            s = wave_sum(s); if (F.lane == 0) *(f32x4*)(statc + 4 * (size_t)r) = (f32x4){s, 0.f, 0.f, 0.f}; }
        if (cqb) { const u32x2 w = *((const u32x2*)(cqb + (size_t)r * QLR) + F.lane); float s = 0.f;
#pragma unroll
            for (int i = 0; i < 2; ++i) { const float a = bflo(w[i]), b = bfhi(w[i]); s += a * a + b * b; }
            s = wave_sum(s); if (F.lane == 0) *(f32x4*)(statq + 4 * (size_t)r) = (f32x4){s, 0.f, 0.f, 0.f}; }
    }
}

template <int W> __device__ __forceinline__ void pool_thread(const float* x, const float* stat, const float* gain, bf16_t* dout, int t0, int c) {
    const float gc = gain[c]; const int pos0 = t0 & (SEQ - 1);
    float hist[W - 1];
#pragma unroll
    for (int j = 0; j < W - 1; ++j) { const int p = pos0 - 1 - j; hist[j] = p >= 0 ? x[(size_t)(t0 - 1 - j) * DM + c] * row_rinv(stat, t0 - 1 - j, 1.0f / DM) : 0.f; }
#pragma unroll 4
    for (int i = 0; i < 32; ++i) {
        const int t = t0 + i, pos = pos0 + i; const float v = x[(size_t)t * DM + c] * row_rinv(stat, t, 1.0f / DM);
        float s = v;
#pragma unroll
        for (int j = 0; j < W - 1; ++j) s += hist[j];
        const int cnt = pos + 1 < W ? pos + 1 : W;
        const float d = (s / (float)cnt - v) * gc;
        dout[(size_t)t * DM + c] = (bf16_t)(cvt_pk_bf16(d, 0.f) & 0xffffu);
#pragma unroll
        for (int j = W - 2; j > 0; --j) hist[j] = hist[j - 1];
        hist[0] = v;
    }
}
__device__ __forceinline__ void pool_prep(const Frame& F, const float* x, const float* stat, const float* gain, bf16_t* dout) {
    for (int u = F.vcu; u < (M / 64) * 4; u += F.G) {
        const int g = u & 3, tt = u >> 2, c = g * 256 + (F.tid & 255), t0 = tt * 64 + (F.tid >> 8) * 32;
        if (g == 0) pool_thread<2>(x, stat, gain, dout, t0, c);
        else if (g == 1) pool_thread<4>(x, stat, gain, dout, t0, c);
        else if (g == 2) pool_thread<8>(x, stat, gain, dout, t0, c);
        else pool_thread<16>(x, stat, gain, dout, t0, c);
    }
}

__device__ __forceinline__ void rope_cs(int pos, int i, float& c, float& s) {
    const float inv = __builtin_amdgcn_exp2f(-(float)i * 0.41524101186092f);
    const float ang = (float)pos * inv;
    const float n = rintf(ang * 0.15915494309189535f);
    float r = fmaf(-n, 6.2831854820251465f, ang); r = fmaf(-n, -1.7484556000744883e-07f, r);
    const float rv = r * 0.15915494309189535f;
    c = __builtin_amdgcn_cosf(rv); s = __builtin_amdgcn_sinf(rv);
}

__device__ __forceinline__ void finalize_k(const Frame& F, const bf16_t* knr, const float* kpe, const float* g_k, const int* positions, bf16_t* kfin) {
    const int l = F.lane;
    for (int t = F.gw; t < M; t += F.ngw) {
        const int b = t / SEQ, s = t % SEQ, pos = positions[t];
        const u32x4 w0 = *(const u32x4*)(knr + (size_t)t * DM + 16 * l), w1 = *(const u32x4*)(knr + (size_t)t * DM + 16 * l + 8);
        float v[16];
#pragma unroll
        for (int i = 0; i < 4; ++i) { v[2 * i] = bflo(w0[i]); v[2 * i + 1] = bfhi(w0[i]); v[8 + 2 * i] = bflo(w1[i]); v[8 + 2 * i + 1] = bfhi(w1[i]); }
        float ss = 0.f;
#pragma unroll
        for (int i = 0; i < 16; ++i) ss += v[i] * v[i];
        ss += __shfl_xor(ss, 1); ss += __shfl_xor(ss, 2); ss += __shfl_xor(ss, 4);
        const float pe = kpe[(size_t)t * DR + l];
        const float pss = wave_sum(pe * pe);
        const float rk = rsqrtf((ss + pss) * (1.0f / DQK) + EPS);
        const int h = l >> 3, c0 = 16 * (l & 7);
        f32x4 o[4];
#pragma unroll
        for (int i = 0; i < 16; ++i) o[i >> 2][i & 3] = v[i] * rk * g_k[c0 + i];
        bf16_t* dst = kfin + ((size_t)(b * NH + h) * SEQ + s) * DQK;
        *(u32x4*)(dst + c0) = pack8(o[0], o[1]); *(u32x4*)(dst + c0 + 8) = pack8(o[2], o[3]);
        const float pg = pe * g_k[DN + l];
        const int i = l & 31; const float x1 = __shfl(pg, i), x2 = __shfl(pg, 32 + i);
        float c, sn; rope_cs(pos, i, c, sn);
        const float outv = l < 32 ? x1 * c - x2 * sn : x2 * c + x1 * sn;
#pragma unroll
        for (int hh = 0; hh < NH; ++hh) { const float rkh = __shfl(rk, 8 * hh); kfin[((size_t)(b * NH + hh) * SEQ + s) * DQK + DN + l] = (bf16_t)(cvt_pk_bf16(outv * rkh, 0.f) & 0xffffu); }
    }
}
__device__ __forceinline__ int kperm16(int p) { return 8 * ((p & 7) >> 2) + 4 * (p >> 3) + (p & 3); }
__device__ __forceinline__ void v_transpose(const Frame& F, const bf16_t* vnat, bf16_t* vt) {
    LAS unsigned char* scr = F.lds + F.wave * 16384; const int l = F.lane;
    for (int u = F.gw; u < BATCH * NH * (SEQ / 64); u += F.ngw) {
        const int bh = u / (SEQ / 64), kt = u % (SEQ / 64), b = bh / NH, h = bh % NH, s0 = kt * 64;
#pragma unroll
        for (int it = 0; it < 16; ++it) { const int key = 4 * it + (l >> 4), ch = l & 15;
            *(LAS u32x4*)(scr + key * 256 + ch * 16) = *(const u32x4*)(vnat + (size_t)(b * SEQ + s0 + key) * DM + h * DV + ch * 8); }
        asm volatile("s_waitcnt lgkmcnt(0)" ::: "memory");
#pragma unroll 4
        for (int w = 0; w < 16; ++w) { const int idx = w * 64 + l, d = idx >> 3, ch = idx & 7; unsigned e[8];
#pragma unroll
            for (int jj = 0; jj < 8; ++jj) { const int p = 8 * ch + jj, key = (p & ~15) + kperm16(p & 15); e[jj] = *(const LAS unsigned short*)(scr + key * 256 + d * 2); }
            u32x4 o; o.x = e[0] | (e[1] << 16); o.y = e[2] | (e[3] << 16); o.z = e[4] | (e[5] << 16); o.w = e[6] | (e[7] << 16);
            *(u32x4*)(vt + ((size_t)bh * DV + d) * SEQ + s0 + 8 * ch) = o; }
        asm volatile("s_waitcnt lgkmcnt(0)" ::: "memory");
    }
}
__device__ __forceinline__ void finalize_q(const Frame& F, bf16_t* q, const float* g_q, const int* positions) {
    LAS float* scr = (LAS float*)(F.lds + F.wave * 16384); const int l = F.lane;
    for (int t = F.gw; t < M; t += F.ngw) {
        const int pos = positions[t];
        bf16_t* row = q + (size_t)t * (NH * DQK) + 24 * l;
        const u32x4 w0 = *(const u32x4*)row, w1 = *(const u32x4*)(row + 8), w2 = *(const u32x4*)(row + 16);
        float v[24];
#pragma unroll
        for (int i = 0; i < 4; ++i) { v[2 * i] = bflo(w0[i]); v[2 * i + 1] = bfhi(w0[i]); v[8 + 2 * i] = bflo(w1[i]); v[8 + 2 * i + 1] = bfhi(w1[i]); v[16 + 2 * i] = bflo(w2[i]); v[16 + 2 * i + 1] = bfhi(w2[i]); }
        float ss = 0.f;
#pragma unroll
        for (int i = 0; i < 24; ++i) ss += v[i] * v[i];
        ss += __shfl_xor(ss, 1); ss += __shfl_xor(ss, 2); ss += __shfl_xor(ss, 4);
        const float rq = rsqrtf(ss * (1.0f / DQK) + EPS) * QSCALE;
        const int c0 = 24 * (l & 7);
#pragma unroll
        for (int i = 0; i < 24; ++i) scr[24 * l + i] = v[i] * rq * g_q[c0 + i];
        asm volatile("s_waitcnt lgkmcnt(0)" ::: "memory");
        const int i = l & 31; float c, sn; rope_cs(pos, i, c, sn);
#pragma unroll
        for (int p = 0; p < 4; ++p) { const int pid = l + 64 * p, h = pid >> 5; LAS float* a = scr + DQK * h + DN + i; const float x1 = a[0], x2 = a[32];
            a[0] = x1 * c - x2 * sn; a[32] = x2 * c + x1 * sn; }
        asm volatile("s_waitcnt lgkmcnt(0)" ::: "memory");
        f32x4 o[6];
#pragma unroll
        for (int k = 0; k < 6; ++k) o[k] = *(const LAS f32x4*)(scr + 24 * l + 4 * k);
        *(u32x4*)row = pack8(o[0], o[1]); *(u32x4*)(row + 8) = pack8(o[2], o[3]); *(u32x4*)(row + 16) = pack8(o[4], o[5]);
        asm volatile("s_waitcnt lgkmcnt(0)" ::: "memory");
    }
}

__device__ __forceinline__ int crow(int r, int hi) { return (r & 3) + 8 * (r >> 2) + 4 * hi; }
__device__ __forceinline__ void attn_simple_unit(const bf16_t* Q, const bf16_t* Kf, const bf16_t* Vt, bf16_t* O, int bh, int qw, int lane) {
    const int c = lane & 31, hi = lane >> 5, b = bh / NH, h = bh % NH;
    const bf16_t* qp = Q + (size_t)(b * SEQ + 32 * qw + c) * (NH * DQK) + h * DQK + 8 * hi;
    bf16x8 qf[12];
#pragma unroll
    for (int st = 0; st < 12; ++st) qf[st] = *(const bf16x8*)(qp + 16 * st);
    f32x16 o[4];
#pragma unroll
    for (int d = 0; d < 4; ++d) o[d] = (f32x16){};
    float m = -1e30f, lsum = 0.f;
    const int nkb = 2 * ((qw >> 1) + 1);
    const bf16_t* kbase = Kf + (size_t)bh * SEQ * DQK + (size_t)c * DQK + 8 * hi;
    const bf16_t* vbase = Vt + ((size_t)bh * DV + c) * SEQ + 8 * hi;
    for (int kb = 0; kb < nkb; ++kb) {
        f32x16 sacc = (f32x16){};
        const bf16_t* kp = kbase + (size_t)(32 * kb) * DQK;
#pragma unroll
        for (int st = 0; st < 12; ++st) { const bf16x8 kf = *(const bf16x8*)(kp + 16 * st); sacc = __builtin_amdgcn_mfma_f32_32x32x16_bf16(kf, qf[st], sacc, 0, 0, 0); }
        float mx = sacc[0];
#pragma unroll
        for (int r = 1; r < 16; ++r) mx = fmaxf(mx, sacc[r]);
        mx = fmaxf(mx, __shfl_xor(mx, 32));
        const float mn = fmaxf(m, mx), alpha = __builtin_amdgcn_exp2f(m - mn);
        float ps = 0.f;
#pragma unroll
        for (int r = 0; r < 16; ++r) { sacc[r] = __builtin_amdgcn_exp2f(sacc[r] - mn); ps += sacc[r]; }
        ps += __shfl_xor(ps, 32);
        lsum = lsum * alpha + ps; m = mn;
#pragma unroll
        for (int d = 0; d < 4; ++d)
#pragma unroll
            for (int r = 0; r < 16; ++r) o[d][r] *= alpha;
        bf16x8 pb[2];
#pragma unroll
        for (int s2 = 0; s2 < 2; ++s2) { u32x4 w; w.x = cvt_pk_bf16(sacc[8 * s2 + 0], sacc[8 * s2 + 1]); w.y = cvt_pk_bf16(sacc[8 * s2 + 2], sacc[8 * s2 + 3]); w.z = cvt_pk_bf16(sacc[8 * s2 + 4], sacc[8 * s2 + 5]); w.w = cvt_pk_bf16(sacc[8 * s2 + 6], sacc[8 * s2 + 7]);
            pb[s2] = __builtin_bit_cast(bf16x8, w); }
#pragma unroll
        for (int d = 0; d < 4; ++d)
#pragma unroll
            for (int s2 = 0; s2 < 2; ++s2) { const bf16x8 vf = *(const bf16x8*)(vbase + (size_t)(32 * d) * SEQ + 32 * kb + 16 * s2); o[d] = __builtin_amdgcn_mfma_f32_32x32x16_bf16(vf, pb[s2], o[d], 0, 0, 0); }
    }
    const float rl = 1.0f / lsum;
    bf16_t* op = O + (size_t)(b * SEQ + 32 * qw + c) * DM + h * DV;
#pragma unroll
    for (int d = 0; d < 4; ++d)
#pragma unroll
        for (int g = 0; g < 4; ++g) { u32x2 w; w.x = cvt_pk_bf16(o[d][4 * g] * rl, o[d][4 * g + 1] * rl); w.y = cvt_pk_bf16(o[d][4 * g + 2] * rl, o[d][4 * g + 3] * rl);
            *(u32x2*)(op + 32 * d + 8 * g + 4 * hi) = w; }
}
__device__ __forceinline__ void attn_simple(const Frame& F, const bf16_t* Q, const bf16_t* Kf, const bf16_t* Vt, bf16_t* O) {
    for (int w = F.gw; w < BATCH * NH * 64; w += F.ngw) {
        const int bh = w >> 6, i = w & 63;
        attn_simple_unit(Q, Kf, Vt, O, bh, 127 - i, F.lane);
        attn_simple_unit(Q, Kf, Vt, O, bh, i, F.lane);
    }
}

struct QKvu {
    bf16_t* knr; bf16_t* vnat; const float* stat;
    __device__ __forceinline__ void quad(int row, int pn, int cin, f32x4 a0, f32x4 a1, f32x4 b0, f32x4 b1) const {
        const float r = row_rinv(stat, row, 1.0f / KVLR);
        bf16_t* o = (pn < 4 ? knr : vnat) + (size_t)row * DM + 256 * (pn & 3) + cin;
        *(u32x4*)o = pack8(a0 * r, a1 * r); *(u32x4*)(o + 128) = pack8(b0 * r, b1 * r);
    }
};

constexpr size_t MiB = 1u << 20;
constexpr size_t WS_CTL = 0, CTL_ZERO_BYTES = 1 * MiB;
constexpr size_t WS_SSQX = 1 * MiB, WS_SSQC = WS_SSQX + 256 * 1024, WS_SSQQ = WS_SSQC + 256 * 1024;
constexpr size_t WS_KPE = 2 * MiB;
constexpr size_t WS_WPOOL = 6 * MiB;
constexpr size_t WS_WKVQ = 7 * MiB;
constexpr size_t WS_WUKV = 9 * MiB;
constexpr size_t WS_WDQ1 = 11 * MiB;
constexpr size_t WS_WUQ = 11 * MiB + 512 * 1024;
constexpr size_t WS_WO = 13 * MiB;
constexpr size_t WS_WGU = 17 * MiB;
constexpr size_t WS_WD = 28 * MiB;
constexpr size_t WS_XB = 34 * MiB;
constexpr size_t WS_VT = 66 * MiB;
constexpr size_t WS_KF = 98 * MiB;
constexpr size_t WS_CKV = 146 * MiB;
constexpr size_t WS_R = 162 * MiB;
constexpr size_t WS_END = 250 * MiB;
constexpr int CW_BAR = 4096;

#define XB_TMO      128
#define XB_XCNT(j)  (256  + 64 * (j))
#define XB_XSUB(j)  (1280 + 64 * (j))
#define XB_XGEN(j)  (2304 + 64 * (j))
#define XB_TOP      3328
#define XB_TOPGEN   3392
#define XCD_BAR_WORDS 3456
#define XB_SPIN_CAP (1u << 18)
__device__ __forceinline__ unsigned xb_ld(unsigned* p)              { return __hip_atomic_load(p, __ATOMIC_RELAXED, __HIP_MEMORY_SCOPE_AGENT); }
__device__ __forceinline__ unsigned xb_add(unsigned* p, unsigned v) { return __hip_atomic_fetch_add(p, v, __ATOMIC_RELAXED, __HIP_MEMORY_SCOPE_AGENT); }
__device__ __forceinline__ unsigned xb_xcc_id() { return (unsigned)__builtin_amdgcn_s_getreg((3 << 11) | 20) & 0xFu; }
#define XB_SPIN(cond, bar) do { unsigned _sp = 0; while (cond) { __builtin_amdgcn_s_sleep(1); \
    if ((++_sp & 255u) == 0u) { if (xb_ld(&(bar)[XB_TMO])) break; if (_sp > XB_SPIN_CAP) { atomicAdd(&(bar)[XB_TMO], 1u); break; } } } } while (0)
struct XcdBarrier { unsigned* bar; unsigned x; volatile LAS unsigned* st; };
__device__ __forceinline__ XcdBarrier xcd_barrier_post(unsigned* bar, volatile LAS unsigned* st) {
    XcdBarrier b; b.bar = bar; b.x = xb_xcc_id(); b.st = st;
    if (threadIdx.x == 0) (void)xb_add(&bar[XB_XCNT(b.x)], 1u);
    return b;
}
__device__ __forceinline__ void xcd_barrier_complete(unsigned* bar, unsigned x, unsigned& nloc, unsigned& nx) {
    const unsigned G = gridDim.x * gridDim.y * gridDim.z;
    unsigned sum, cnt, mine, sp = 0u;
    for (;;) {
        sum = 0u; cnt = 0u; mine = 0u;
#pragma unroll
        for (unsigned j = 0; j < 16; ++j) { const unsigned c = xb_ld(&bar[XB_XCNT(j)]); sum += c; cnt += (c > 0u) ? 1u : 0u; mine = (j == x) ? c : mine; }
        if (sum == G) break;
        __builtin_amdgcn_s_sleep(1);
        if ((++sp & 255u) == 0u) { if (xb_ld(&bar[XB_TMO])) break; if (sp > XB_SPIN_CAP) { atomicAdd(&bar[XB_TMO], 1u); break; } }
    }
    nloc = mine > 0u ? mine : 1u; nx = cnt > 0u ? cnt : 1u;
}
__device__ __forceinline__ void xcd_barrier(const XcdBarrier& b) {
    asm volatile("s_waitcnt vmcnt(0)" ::: "memory");
    __syncthreads();
    if (threadIdx.x == 0) {
        unsigned* bar = b.bar;
        __builtin_amdgcn_s_waitcnt(0);
        unsigned nloc = b.st[0], nx = b.st[1];
        if (nloc == 0u) { xcd_barrier_complete(bar, b.x, nloc, nx); b.st[0] = nloc; b.st[1] = nx; }
        const unsigned old = xb_add(&bar[XB_XSUB(b.x)], 1u);
        const unsigned gen = old / nloc;
        if (old + 1u == (gen + 1u) * nloc) {
            __builtin_amdgcn_fence(__ATOMIC_RELEASE, "agent");
            asm volatile("s_waitcnt vmcnt(0)" ::: "memory");
            const unsigned og = xb_add(&bar[XB_TOP], 1u);
            const unsigned tg = og / nx;
            if (og + 1u == (tg + 1u) * nx) xb_add(&bar[XB_TOPGEN], 1u);
            else XB_SPIN(xb_ld(&bar[XB_TOPGEN]) == tg, bar);
            __builtin_amdgcn_fence(__ATOMIC_ACQUIRE, "agent");
            xb_add(&bar[XB_XGEN(b.x)], 1u);
            asm volatile("s_waitcnt vmcnt(0)" ::: "memory");
        } else {
            XB_SPIN(xb_ld(&bar[XB_XGEN(b.x)]) == gen, bar);
            __builtin_amdgcn_fence(__ATOMIC_ACQUIRE, "agent");
            asm volatile("s_waitcnt vmcnt(0)" ::: "memory");
        }
    }
    __syncthreads();
}

#ifndef GEMM_MODE
#define GEMM_MODE 1
#endif
#ifndef ONE_LAUNCH
#define ONE_LAUNCH 1
#endif
constexpr int NPH = 34;
struct Args { const void* in[22]; float* out; unsigned char* ws; int lo, hi; };

template <class Q> __device__ __forceinline__ void run_gemm(const Frame& F, const pg8::Gemm g, const Q& q) {
#if GEMM_MODE == 0
    pg8::gemm_simple<Q>(g, q, F.gw, F.ngw, F.lane);
#else
    pg8::StaticOrder S; S.init(g.M, g.N, F.G, (int)blockIdx.x);
    const pg8::EpiQuad<Q> E{q};
    pg8::gemm_phase<pg8::EpiQuad<Q>, pg8::StaticOrder, true, true>(F.lds, g, S, E, F.tid);
#endif
}

__global__ void __launch_bounds__(NWAVES * 64, 2) mk_fwd(Args args) {
    extern __shared__ __attribute__((aligned(16))) unsigned char lds_raw[];
    Frame F0;
    F0.lds = (LAS unsigned char*)lds_raw; F0.MISC = (volatile LAS unsigned*)(F0.lds + MISC_OFF);
    F0.tid = threadIdx.x; F0.lane = F0.tid & 63; F0.wave = __builtin_amdgcn_readfirstlane(F0.tid >> 6);
    F0.G = gridDim.x; { const int bx = blockIdx.x; F0.vcu = (F0.G % 8 == 0) ? (bx % 8) * (F0.G / 8) + bx / 8 : bx; }
    F0.gw = F0.vcu * NWAVES + F0.wave; F0.ngw = F0.G * NWAVES;
    for (int u = F0.tid; u < (LDS_BYTES - RING_BYTES) / 4; u += NWAVES * 64) ((LAS unsigned*)(F0.lds + RING_BYTES))[u] = 0u;
    __syncthreads();
    unsigned char* ws = args.ws;
    XcdBarrier bar; bar.bar = (unsigned*)(ws + WS_CTL) + CW_BAR; bar.x = 0; bar.st = nullptr;
#if ONE_LAUNCH
    bar = xcd_barrier_post((unsigned*)(ws + WS_CTL) + CW_BAR, F0.MISC + 8);
#endif
    const float* x_in = (const float*)args.in[0]; const int* positions = (const int*)args.in[1];
    const float* ln_mix_a = (const float*)args.in[2]; const float* w_pool = (const float*)args.in[3]; const float* b_pool = (const float*)args.in[4]; const float* pool_scale = (const float*)args.in[5];
    const float* ln_ffn = (const float*)args.in[6]; const float* w_gate = (const float*)args.in[7]; const float* w_up = (const float*)args.in[8]; const float* w_down = (const float*)args.in[9];
    const float* ln_kv = (const float*)args.in[10]; const float* w_dkv = (const float*)args.in[11]; const float* g_kv_latent = (const float*)args.in[12]; const float* w_uk = (const float*)args.in[13];
    const float* w_uv = (const float*)args.in[14]; const float* g_k = (const float*)args.in[15]; const float* ln_mix_b = (const float*)args.in[16]; const float* w_dq = (const float*)args.in[17];
    const float* g_q_latent = (const float*)args.in[18]; const float* w_uq = (const float*)args.in[19]; const float* g_q = (const float*)args.in[20]; const float* w_o = (const float*)args.in[21];
    float* xo = args.out;
    float* ssqx = (float*)(ws + WS_SSQX); float* ssqc = (float*)(ws + WS_SSQC); float* ssqq = (float*)(ws + WS_SSQQ); float* kpe = (float*)(ws + WS_KPE);
    bf16_t* Wpool_t = (bf16_t*)(ws + WS_WPOOL); bf16_t* Wkvq_t = (bf16_t*)(ws + WS_WKVQ); bf16_t* Wukv_t = (bf16_t*)(ws + WS_WUKV); bf16_t* Wdq1_t = (bf16_t*)(ws + WS_WDQ1);
    bf16_t* Wuq_t = (bf16_t*)(ws + WS_WUQ); bf16_t* Wo_t = (bf16_t*)(ws + WS_WO); bf16_t* Wgu_t = (bf16_t*)(ws + WS_WGU); bf16_t* Wd_t = (bf16_t*)(ws + WS_WD);
    bf16_t* xb = (bf16_t*)(ws + WS_XB); bf16_t* vt = (bf16_t*)(ws + WS_VT); bf16_t* kfin = (bf16_t*)(ws + WS_KF); bf16_t* ckvb = (bf16_t*)(ws + WS_CKV);
    bf16_t* hid = (bf16_t*)(ws + WS_R); bf16_t* dpool = (bf16_t*)(ws + WS_R); bf16_t* Qb = (bf16_t*)(ws + WS_R); bf16_t* vnat = (bf16_t*)(ws + WS_R);
    bf16_t* Ob = (bf16_t*)(ws + WS_R + 48 * MiB); bf16_t* knr = (bf16_t*)(ws + WS_R + 48 * MiB); bf16_t* cqb = (bf16_t*)(ws + WS_R + 80 * MiB);

    const int lo = args.lo, hi = args.hi; int ph = 0;
#define PH_BEGIN if (ph >= lo && ph < hi) { Frame F = F0; asm volatile("" : "+v"(F.tid), "+v"(F.lane));
#define PH_END   if (ph + 1 < hi) xcd_barrier(bar); } ++ph;
#define PREP_FFN(l) do { prep_mat(F, w_gate + (size_t)(l) * DM * DFF, DFF, DM, DFF, 0, ln_ffn + (l) * DM, Wgu_t, RM_GATE, 0); \
                         prep_mat(F, w_up + (size_t)(l) * DM * DFF, DFF, DM, DFF, 0, ln_ffn + (l) * DM, Wgu_t, RM_UP, 0); \
                         prep_mat(F, w_down + (size_t)(l) * DFF * DM, DM, DFF, DM, 0, nullptr, Wd_t, RM_PLAIN, 0); } while (0)

    PH_BEGIN
        for (int l = 0; l < 2; ++l) for (int g = 0; g < 4; ++g)
            prep_mat(F, w_pool + (size_t)(l * 4 + g) * 65536, 256, 256, 256, 0, nullptr, Wpool_t + (size_t)l * 1024 * 256, RM_PLAIN, 256 * g);
        prep_mat(F, w_dkv, 576, DM, 512, 0, ln_kv, Wkvq_t, RM_PLAIN, 0);
        prep_mat(F, w_dq, QLR, DM, QLR, 0, ln_mix_b, Wkvq_t, RM_PLAIN, 512);
        prep_mat(F, w_dkv, 576, DM, DR, 512, ln_kv, Wkvq_t, RM_PLAIN, 768);
        for (int i = F.vcu * 512 + F.tid; i < 192 * 1024 / 8; i += F.G * 512) *(u32x4*)(Wkvq_t + (size_t)832 * 1024 + 8 * (size_t)i) = (u32x4){0u, 0u, 0u, 0u};
        prep_mat(F, w_uk, DM, KVLR, DM, 0, g_kv_latent, Wukv_t, RM_PLAIN, 0);
        prep_mat(F, w_uv, DM, KVLR, DM, 0, g_kv_latent, Wukv_t, RM_PLAIN, 1024);
        prep_mat(F, w_dq + (size_t)DM * QLR, QLR, DM, QLR, 0, ln_mix_b + DM, Wdq1_t, RM_PLAIN, 0);
        for (int j = 0; j < 2; ++j) prep_mat(F, w_uq + (size_t)j * QLR * 1536, 1536, QLR, 1536, 0, g_q_latent + j * QLR, Wuq_t + (size_t)j * 1536 * QLR, RM_PLAIN, 0);
        for (int j = 0; j < 2; ++j) prep_mat(F, w_o + (size_t)j * DM * DM, DM, DM, DM, 0, nullptr, Wo_t + (size_t)j * DM * DM, RM_PLAIN, 0);
        PREP_FFN(0);
        rowstat_x(F, x_in, ssqx);
    PH_END

    for (int l = 0; l < 4; ++l) {
        if (l < 2) {
            const float* xsrc = l == 0 ? x_in : xo;
            PH_BEGIN pool_prep(F, xsrc, ssqx, ln_mix_a + l * DM, dpool); PH_END
            PH_BEGIN { const pg8::Gemm g{dpool, Wpool_t + (size_t)l * 1024 * 256, M, DM, 256, DM, 256, 256};
                       const QResidual q{xsrc, xo, xb, b_pool + l * DM, pool_scale + l * DM}; run_gemm(F, g, q); } PH_END
            PH_BEGIN rowstat_x(F, xo, ssqx); PH_END
        } else {
            const int j = l - 2;
            if (j == 1) {
                PH_BEGIN { const pg8::Gemm g{xb, Wdq1_t, M, QLR, DM, DM, DM, 0}; const QRowScale q{cqb, QLR, ssqx, 1.0f / DM}; run_gemm(F, g, q); } PH_END
                PH_BEGIN rowstat_lat(F, nullptr, nullptr, cqb, ssqq); PH_END
            }
            PH_BEGIN { const pg8::Gemm g{cqb, Wuq_t + (size_t)j * 1536 * QLR, M, 1536, QLR, QLR, QLR, 0}; const QRowScale q{Qb, 1536, ssqq, 1.0f / QLR}; run_gemm(F, g, q); } PH_END
            PH_BEGIN finalize_q(F, Qb, g_q + j * DQK, positions); PH_END
            PH_BEGIN attn_simple(F, Qb, kfin, vt, Ob); PH_END
            PH_BEGIN { const pg8::Gemm g{Ob, Wo_t + (size_t)j * DM * DM, M, DM, DM, DM, DM, 0}; const QResidual q{xo, xo, xb, nullptr, nullptr}; run_gemm(F, g, q); } PH_END
            PH_BEGIN rowstat_x(F, xo, ssqx); PH_END
        }
        PH_BEGIN { const pg8::Gemm g{xb, Wgu_t, M, NGU, DM, DM, DM, 0}; const QGateUp q{hid, ssqx}; run_gemm(F, g, q); } PH_END
        PH_BEGIN { const pg8::Gemm g{hid, Wd_t, M, DM, DFF, DFF, DFF, 0}; const QResidual q{xo, xo, xb, nullptr, nullptr}; run_gemm(F, g, q); } PH_END
        if (l < 3) { PH_BEGIN rowstat_x(F, xo, ssqx); PREP_FFN(l + 1); PH_END }
        if (l == 1) {
            PH_BEGIN { const pg8::Gemm g{xb, Wkvq_t, M, DM, DM, DM, DM, 0}; const QKvd q{ckvb, cqb, kpe, ssqx}; run_gemm(F, g, q); } PH_END
            PH_BEGIN rowstat_lat(F, ckvb, ssqc, cqb, ssqq); PH_END
            PH_BEGIN { const pg8::Gemm g{ckvb, Wukv_t, M, 2048, KVLR, KVLR, KVLR, 0}; const QKvu q{knr, vnat, ssqc}; run_gemm(F, g, q); } PH_END
            PH_BEGIN finalize_k(F, knr, kpe, g_k, positions, kfin); v_transpose(F, vnat, vt); PH_END
        }
    }
#undef PH_BEGIN
#undef PH_END
#undef PREP_FFN
}

extern "C" void kernel_launch(void* const* d_in, const int* in_sizes, int n_in, void* d_out, int out_size, void* d_ws, size_t ws_size, hipStream_t stream) {
    static int grid = 0;
    if (grid == 0) {
        if (n_in != 22 || in_sizes[0] != M * DM || out_size != M * DM || ws_size < WS_END) { fprintf(stderr, "kernel_launch: unexpected shapes (n_in %d, in0 %d, out %d, ws %zu)\n", n_in, n_in > 0 ? in_sizes[0] : -1, out_size, ws_size); grid = -1; return; }
        int dev = 0, cus = 0, per_cu = 0;
        if (hipGetDevice(&dev) != hipSuccess || hipDeviceGetAttribute(&cus, hipDeviceAttributeMultiprocessorCount, dev) != hipSuccess) { grid = -1; return; }
        if (hipFuncSetAttribute((const void*)mk_fwd, hipFuncAttributeMaxDynamicSharedMemorySize, LDS_BYTES) != hipSuccess) { fprintf(stderr, "kernel_launch: hipFuncSetAttribute failed\n"); grid = -1; return; }
        if (hipOccupancyMaxActiveBlocksPerMultiprocessor(&per_cu, (const void*)mk_fwd, NWAVES * 64, LDS_BYTES) != hipSuccess || per_cu < 1) { fprintf(stderr, "kernel_launch: occupancy query reports %d blocks per CU\n", per_cu); grid = -1; (void)hipGetLastError(); return; }
        grid = cus;
    }
    if (grid < 0) return;
    if (hipMemsetAsync((char*)d_ws + WS_CTL, 0, CTL_ZERO_BYTES, stream) != hipSuccess) return;
    Args a{};
    for (int i = 0; i < 22; ++i) a.in[i] = d_in[i];
    a.out = (float*)d_out; a.ws = (unsigned char*)d_ws;
#if ONE_LAUNCH
    a.lo = 0; a.hi = NPH;
    hipLaunchKernelGGL(mk_fwd, dim3(grid), dim3(NWAVES * 64), LDS_BYTES, stream, a);
#else
    for (int p = 0; p < NPH; ++p) { a.lo = p; a.hi = p + 1; hipLaunchKernelGGL(mk_fwd, dim3(grid), dim3(NWAVES * 64), LDS_BYTES, stream, a); }
#endif
}
```

```cpp
#define GROUP_SEAMS true
#define LIGHT_SEAMS true
#include <hip/hip_runtime.h>
#include <cstdio>
#include <cstdint>

#define LAS __attribute__((address_space(3)))
#define GAS __attribute__((address_space(1)))
typedef unsigned short bf16_t;
typedef short bf16x8 __attribute__((ext_vector_type(8)));
typedef float f32x4 __attribute__((ext_vector_type(4)));
typedef float f32x16 __attribute__((ext_vector_type(16)));
typedef unsigned u32x4 __attribute__((ext_vector_type(4)));
typedef unsigned u32x2 __attribute__((ext_vector_type(2)));

constexpr int BATCH = 4, SEQ = 4096, DM = 1024, M = BATCH * SEQ, DFF = 2816, NH = 8, DN = 128, DR = 64, DQK = 192, DV = 128, QLR = 256, KVLR = 512;
constexpr int NGU = 2 * DFF;
constexpr float EPS = 1e-6f;
constexpr float QSCALE = 0.07216878364870322f * 1.4426950408889634f;

__device__ __forceinline__ unsigned cvt_pk_bf16(float lo, float hi) { unsigned r; asm volatile("v_cvt_pk_bf16_f32 %0, %1, %2" : "=v"(r) : "v"(lo), "v"(hi)); return r; }
__device__ __forceinline__ u32x4 pack8(f32x4 a, f32x4 b) { u32x4 w; w.x = cvt_pk_bf16(a[0], a[1]); w.y = cvt_pk_bf16(a[2], a[3]); w.z = cvt_pk_bf16(b[0], b[1]); w.w = cvt_pk_bf16(b[2], b[3]); return w; }
__device__ __forceinline__ float bf2f(unsigned v) { return __uint_as_float(v << 16); }
__device__ __forceinline__ float bflo(unsigned w) { return __uint_as_float(w << 16); }
__device__ __forceinline__ float bfhi(unsigned w) { return __uint_as_float(w & 0xffff0000u); }
__device__ __forceinline__ int lane_now() { unsigned l; asm volatile("v_mbcnt_lo_u32_b32 %0, -1, 0\n\tv_mbcnt_hi_u32_b32 %0, -1, %0" : "=v"(l)); return (int)l; }
template <int N> __device__ __forceinline__ float xshfl(float v) {
    static_assert(N < 32, "xshfl: use sum32 / max32 across the halves");
    return __int_as_float(__builtin_amdgcn_ds_swizzle(__float_as_int(v), 0x1F | (N << 10)));
}
__device__ __forceinline__ float wave_sum(float v) {
    v += xshfl<1>(v); v += xshfl<2>(v); v += xshfl<4>(v); v += xshfl<8>(v); v += xshfl<16>(v);
    { const auto rr = __builtin_amdgcn_permlane32_swap(__float_as_uint(v), __float_as_uint(v), false, false); v = __uint_as_float(rr[0]) + __uint_as_float(rr[1]); }
    return v;
}
__device__ __forceinline__ float sum32(float v) { const auto rr = __builtin_amdgcn_permlane32_swap(__float_as_uint(v), __float_as_uint(v), false, false); return __uint_as_float(rr[0]) + __uint_as_float(rr[1]); }
__device__ __forceinline__ float max32(float v) { const auto rr = __builtin_amdgcn_permlane32_swap(__float_as_uint(v), __float_as_uint(v), false, false); return fmaxf(__uint_as_float(rr[0]), __uint_as_float(rr[1])); }
__device__ __forceinline__ float row_rinv(const float* stat, int row, float invn) { const f32x4 p = *(const f32x4*)(stat + 4 * (size_t)row); return rsqrtf(((p.x + p.y) + (p.z + p.w)) * invn + EPS); }

namespace pg8 {
constexpr int BM = 256, BK = 64, HALF = 128, HTB = HALF * BK * 2  , STAGE_BYTES = 8 * HTB, NXCD = 8, WGM = 8;
__host__ __device__ __forceinline__ int lds_byte(int r, int c) { const int st = (r >> 4) * 2 + (c >> 5), rr = r & 15, cc = c & 31, ob = rr * 64 + cc * 2; return st * 1024 + (ob ^ (((ob >> 9) & 1) << 5)); }
__host__ __device__ __forceinline__ void stage_rc(int b, int& R, int& C) { const int st = b / 1024, sb = b % 1024, swz = sb ^ (((sb >> 9) & 1) << 5); R = (st >> 1) * 16 + swz / 64; C = (st & 1) * 32 + (swz % 64) / 2; }
__host__ __device__ __forceinline__ int perm32(int rho) { const int n = rho >> 4, i = rho & 15; return 8 * (i >> 2) + 4 * n + (i & 3); }

struct Unit { int pm, pn; };
struct Gemm { const bf16_t* A; const bf16_t* Bt; int M, N, K, lda, ldb, a_pn_stride; size_t a_tstep; };

struct StaticOrder {
    int nM, nN, nwg, G, c;
    __host__ __device__ __forceinline__ void init(int M, int N, int G_, int c_) { nM = M / BM; nN = N / BM; nwg = nM * nN; G = G_; c = c_; }
    __host__ __device__ __forceinline__ bool next(int i, Unit& u) const {
        const long L = (long)i * G + c; if (L >= nwg) return false;
        int wgid = (int)L; { const int q = nwg / NXCD, r = nwg % NXCD, xcd = wgid % NXCD, off = wgid / NXCD; wgid = (xcd < r ? xcd * (q + 1) : r * (q + 1) + (xcd - r) * q) + off; }
        const int nig = WGM * nN, gid = wgid / nig, fm = gid * WGM, gsz = (nM - fm) < WGM ? (nM - fm) : WGM;
        u.pm = fm + ((wgid % nig) % gsz); u.pn = (wgid % nig) / gsz; return true;
    }
    __device__ __forceinline__ void a_ready(const Unit&) const {}
    __device__ __forceinline__ void done(const Unit&) const {}
};

struct LimitOrder {
    StaticOrder S; int lim;
    __device__ __forceinline__ bool next(int i, Unit& u) const { return i < lim && S.next(i, u); }
    __device__ __forceinline__ void a_ready(const Unit&) const {}
    __device__ __forceinline__ void done(const Unit&) const {}
};
struct OneUnit {
    Unit u; bool ok;
    __device__ __forceinline__ bool next(int i, Unit& o) const { if (i != 0 || !ok) return false; o = u; return true; }
    __device__ __forceinline__ void a_ready(const Unit&) const {}
    __device__ __forceinline__ void done(const Unit&) const {}
};

template <class Q> struct EpiQuad {
    static constexpr bool PERM = true, AFTER_DRAIN = false;
    Q q;
    __device__ __forceinline__ void operator()(const f32x4 (&acc)[2][2][4][2], const Unit& u, int wr, int wc, int fr, int fq) const {
        { const int ln = lane_now(); fr = ln & 15; fq = ln >> 4; }
        const int cin = wc * 32 + 8 * fq;
#pragma unroll
        for (int ai = 0; ai < 2; ++ai) {
            typename Q::Pre pre[4];
#pragma unroll
            for (int m = 0; m < 4; ++m) pre[m] = q.preload(u.pm * BM + ai * HALF + wr * 64 + m * 16 + fr, u.pn, cin);
#pragma unroll
            for (int m = 0; m < 4; ++m) {
                const int row = u.pm * BM + ai * HALF + wr * 64 + m * 16 + fr;
                q.quad(row, u.pn, cin, acc[ai][0][m][0], acc[ai][0][m][1], acc[ai][1][m][0], acc[ai][1][m][1], pre[m]);
            }
            __builtin_amdgcn_sched_barrier(0);
        }
    }
};

template <class Q, class = void> struct epi_deep { static constexpr bool value = false; };
template <class Q> struct epi_deep<Q, decltype((void)Q::DEEP)> { static constexpr bool value = Q::DEEP; };
template <class Q> struct EpiQuadStat {
    static constexpr bool PERM = true, AFTER_DRAIN = false;
    Q q; LAS float* P; int tid;
    __device__ __forceinline__ void operator()(const f32x4 (&acc)[2][2][4][2], const Unit& u, int wr, int wc, int fr, int fq) const {
        const int ln = lane_now(); fr = ln & 15; fq = ln >> 4;
        const int tl = (wr * 4 + wc) * 64 + ln;
        const int cin = wc * 32 + 8 * fq;
        LAS float* Pw = P + (wr * 64 + fr) * 4 + wc;
        bool done_deep = false;
        if constexpr (epi_deep<Q>::value) {
            if (q.deep_ok()) {
                done_deep = true;
                typename Q::PreRaw pr[2][4];
#pragma unroll
                for (int ai = 0; ai < 2; ++ai)
#pragma unroll
                    for (int m = 0; m < 4; ++m) pr[ai][m] = q.preload_raw(u.pm * BM + ai * HALF + wr * 64 + m * 16 + fr, u.pn, cin);
                __builtin_amdgcn_sched_barrier(0);
#pragma unroll
                for (int ai = 0; ai < 2; ++ai) {
#pragma unroll
                    for (int m = 0; m < 4; ++m) {
                        const int rl = ai * HALF + wr * 64 + m * 16 + fr;
                        float ss = q.quad_raw(u.pm * BM + rl, u.pn, cin, acc[ai][0][m][0], acc[ai][0][m][1], acc[ai][1][m][0], acc[ai][1][m][1], pr[ai][m]);
                        ss += xshfl<16>(ss); ss = sum32(ss);
                        if (fq == 0) Pw[(ai * HALF + m * 16) * 4] = ss;
                    }
                    __builtin_amdgcn_sched_barrier(0);
                }
            }
        }
        if (!done_deep)
#pragma unroll
        for (int ai = 0; ai < 2; ++ai) {
            typename Q::Pre pre[4];
#pragma unroll
            for (int m = 0; m < 4; ++m) pre[m] = q.preload(u.pm * BM + ai * HALF + wr * 64 + m * 16 + fr, u.pn, cin);
#pragma unroll
            for (int m = 0; m < 4; ++m) {
                const int rl = ai * HALF + wr * 64 + m * 16 + fr;
                float ss = q.quad(u.pm * BM + rl, u.pn, cin, acc[ai][0][m][0], acc[ai][0][m][1], acc[ai][1][m][0], acc[ai][1][m][1], pre[m]);
                ss += xshfl<16>(ss); ss = sum32(ss);
                if (fq == 0) Pw[(ai * HALF + m * 16) * 4] = ss;
            }
            __builtin_amdgcn_sched_barrier(0);
        }
        asm volatile("s_waitcnt lgkmcnt(0)" ::: "memory"); __builtin_amdgcn_s_barrier(); asm volatile("" ::: "memory");
        if (tl < 256) { const f32x4 p = *(const LAS f32x4*)(P + 4 * tl); q.put_stat(u.pm * BM + tl, u.pn, (p.x + p.y) + (p.z + p.w)); }
        asm volatile("s_waitcnt lgkmcnt(0)" ::: "memory");
    }
};

struct NoHook { __device__ __forceinline__ void operator()() const {} };
template <class Epi, class Sched, bool ALIGN_EPI = false, bool SP2 = false, class Hook = NoHook>
__device__ __forceinline__ void gemm_phase(LAS unsigned char* lds, const Gemm g, const Sched& S, const Epi& E, const int tid, const Hook& hook = Hook()) {
    const int wid = __builtin_amdgcn_readfirstlane(tid >> 6), lane = tid & 63, wr = wid >> 2, wc = wid & 3, fr = lane & 15, fq = lane >> 4;
    const int K = g.K, nt = K / BK;
    unsigned voffA[2], voffB[2];
#pragma unroll
    for (int i = 0; i < 2; ++i) { int R, C; stage_rc(tid * 16 + i * 8192, R, C); const int Rb = Epi::PERM ? ((R & ~31) + perm32(R & 31)) : R;
        voffA[i] = (unsigned)(R * g.lda + C) * 2u; voffB[i] = (unsigned)(Rb * g.ldb + C) * 2u; }
    const size_t kstep = (size_t)(BK * 2);
    const size_t hstepA = (size_t)HALF * g.lda * 2, hstepB = (size_t)HALF * g.ldb * 2;
    const size_t tstepA = g.a_tstep ? g.a_tstep : 2 * hstepA, tstepB = 2 * hstepB;
    const size_t pnA = (size_t)g.a_pn_stride * 2;
    const unsigned ldsw = (unsigned)wid * 1024u;
    const int aoff = lds_byte(wr * 64 + fr, fq * 8), boff = lds_byte(wc * 32 + fr, fq * 8);
#define PG8_SA(b, h) (((b) * 2 + (h)) * HTB)
#define PG8_SB(b, h) ((4 + (b) * 2 + (h)) * HTB)
    const __amdgpu_buffer_rsrc_t rsA = __builtin_amdgcn_make_buffer_rsrc((void*)g.A, 0, 0x7ffffffc, 0x00020000), rsB = __builtin_amdgcn_make_buffer_rsrc((void*)g.Bt, 0, 0x7ffffffc, 0x00020000);
    const char* const baseA = (const char*)g.A; const char* const baseB = (const char*)g.Bt;
#define PG8_STAGEA(bufoff, gbase, voff) do { _Pragma("unroll") for (int _i = 0; _i < 2; ++_i) \
        __builtin_amdgcn_raw_ptr_buffer_load_lds(rsA, (LAS void*)(lds + (bufoff) + ldsw + _i * 8192), 16, (voff)[_i], (unsigned)((const char*)(gbase) - baseA), 0, 0); } while (0)
#define PG8_STAGEB(bufoff, gbase, voff) do { _Pragma("unroll") for (int _i = 0; _i < 2; ++_i) \
        __builtin_amdgcn_raw_ptr_buffer_load_lds(rsB, (LAS void*)(lds + (bufoff) + ldsw + _i * 8192), 16, (voff)[_i], (unsigned)((const char*)(gbase) - baseB), 0, 0); } while (0)
#define PG8_LDA(dst, b, h) do { _Pragma("unroll") for (int m = 0; m < 4; ++m) _Pragma("unroll") for (int k = 0; k < 2; ++k) dst[m][k] = *(const LAS bf16x8*)(lds + PG8_SA(b, h) + aoff + m * 2048 + k * 1024); } while (0)
#define PG8_LDB(dst, b, h) do { _Pragma("unroll") for (int n = 0; n < 2; ++n) _Pragma("unroll") for (int k = 0; k < 2; ++k) dst[n][k] = *(const LAS bf16x8*)(lds + PG8_SB(b, h) + boff + n * 2048 + k * 1024); } while (0)
#define PG8_MMA(ai, bj, At, Bt) do { __builtin_amdgcn_s_setprio(1); _Pragma("unroll") for (int m = 0; m < 4; ++m) _Pragma("unroll") for (int n = 0; n < 2; ++n) _Pragma("unroll") for (int k = 0; k < 2; ++k) \
        acc[ai][bj][m][n] = __builtin_amdgcn_mfma_f32_16x16x32_bf16(Bt[n][k], At[m][k], acc[ai][bj][m][n], 0, 0, 0); __builtin_amdgcn_s_setprio(0); } while (0)
#define PG8_WAIT_V(n) asm volatile("s_waitcnt vmcnt(" #n ")" ::: "memory")
#define PG8_WAIT_L(n) asm volatile("s_waitcnt lgkmcnt(" #n ")" ::: "memory")
#define PG8_BAR __builtin_amdgcn_s_barrier()
#define PG8_SCHED __builtin_amdgcn_sched_barrier(0)
    Unit cur, nxt; int ui = 0;
    if (!S.next(0, cur)) return;
    f32x4 acc[2][2][4][2];
#pragma unroll
    for (int a = 0; a < 2; ++a)
#pragma unroll
        for (int b = 0; b < 2; ++b)
#pragma unroll
            for (int m = 0; m < 4; ++m)
#pragma unroll
                for (int n = 0; n < 2; ++n) acc[a][b][m][n] = (f32x4){0.f, 0.f, 0.f, 0.f};
    bf16x8 At[4][2], B0[2][2], B1[2][2];
    const char* cA = (const char*)g.A + (size_t)cur.pm * tstepA + (size_t)cur.pn * pnA; const char* cB = (const char*)g.Bt + (size_t)cur.pn * tstepB;
    S.a_ready(cur);
    if constexpr (SP2) {
        PG8_STAGEB(PG8_SB(0, 0), cB, voffB); PG8_STAGEB(PG8_SB(0, 1), cB + hstepB, voffB); PG8_STAGEA(PG8_SA(0, 0), cA, voffA); PG8_STAGEA(PG8_SA(0, 1), cA + hstepA, voffA);
        if (wr == 1) PG8_BAR;
        PG8_WAIT_V(2); hook(); PG8_BAR;
        PG8_STAGEB(PG8_SB(1, 0), cB + kstep, voffB); PG8_STAGEA(PG8_SA(1, 0), cA + kstep, voffA); PG8_STAGEB(PG8_SB(1, 1), cB + hstepB + kstep, voffB);
        PG8_WAIT_V(6); PG8_BAR;
    } else {
        PG8_STAGEB(PG8_SB(0, 0), cB, voffB); PG8_STAGEA(PG8_SA(0, 0), cA, voffA); PG8_STAGEB(PG8_SB(0, 1), cB + hstepB, voffB); PG8_STAGEA(PG8_SA(0, 1), cA + hstepA, voffA);
        if (wr == 1) PG8_BAR;
        PG8_WAIT_V(4); PG8_BAR;
        PG8_STAGEB(PG8_SB(1, 0), cB + kstep, voffB); PG8_STAGEA(PG8_SA(1, 0), cA + kstep, voffA); PG8_STAGEB(PG8_SB(1, 1), cB + hstepB + kstep, voffB);
        PG8_WAIT_V(6); PG8_BAR;
    }
    for (;;) {
        const bool has_next = S.next(ui + 1, nxt);
        const char* nA = has_next ? (const char*)g.A + (size_t)nxt.pm * tstepA + (size_t)nxt.pn * pnA : cA; const char* nB = has_next ? (const char*)g.Bt + (size_t)nxt.pn * tstepB : cB;
        for (int t = 0; t < nt; t += 2) {
            const bool last = (t == nt - 2);
            const char* a1 = cA + (size_t)(t + 1) * kstep;
            const char* a2 = last ? nA : cA + (size_t)(t + 2) * kstep; const char* b2 = last ? nB : cB + (size_t)(t + 2) * kstep;
            const char* a3 = a2 + kstep; const char* b3 = b2 + kstep;
            if (last && has_next) S.a_ready(nxt);
            if constexpr (SP2) {
            PG8_LDB(B0, 0, 0); PG8_LDB(B1, 0, 1); PG8_SCHED; PG8_LDA(At, 0, 0); PG8_STAGEA(PG8_SA(1, 1), a1 + hstepA, voffA);
            PG8_WAIT_V(8); PG8_WAIT_L(0); PG8_BAR; PG8_MMA(0, 0, At, B0); PG8_MMA(0, 1, At, B1); PG8_BAR; PG8_SCHED;
            PG8_LDA(At, 0, 1); PG8_STAGEB(PG8_SB(0, 0), b2, voffB); PG8_STAGEB(PG8_SB(0, 1), b2 + hstepB, voffB); PG8_STAGEA(PG8_SA(0, 0), a2, voffA);
            PG8_WAIT_V(8); PG8_WAIT_L(0); PG8_BAR; PG8_MMA(1, 0, At, B0); PG8_MMA(1, 1, At, B1); PG8_BAR; PG8_SCHED;
            PG8_LDB(B0, 1, 0); PG8_LDB(B1, 1, 1); PG8_SCHED; PG8_LDA(At, 1, 0); PG8_STAGEA(PG8_SA(0, 1), a2 + hstepA, voffA);
            PG8_WAIT_V(8); PG8_WAIT_L(0); PG8_BAR; PG8_MMA(0, 0, At, B0); PG8_MMA(0, 1, At, B1); PG8_BAR; PG8_SCHED;
            PG8_LDA(At, 1, 1); PG8_STAGEB(PG8_SB(1, 0), b3, voffB); PG8_STAGEB(PG8_SB(1, 1), b3 + hstepB, voffB); PG8_STAGEA(PG8_SA(1, 0), a3, voffA);
            PG8_WAIT_V(8); PG8_WAIT_L(0); PG8_BAR; PG8_MMA(1, 0, At, B0); PG8_MMA(1, 1, At, B1); PG8_BAR; PG8_SCHED;
            } else {
            PG8_LDB(B0, 0, 0); PG8_SCHED; PG8_LDA(At, 0, 0); PG8_STAGEA(PG8_SA(1, 1), a1 + hstepA, voffA);
            PG8_WAIT_L(8); PG8_BAR; PG8_WAIT_L(0); PG8_MMA(0, 0, At, B0); PG8_BAR; PG8_SCHED;
            PG8_LDB(B1, 0, 1); PG8_STAGEB(PG8_SB(0, 0), b2, voffB);
            PG8_BAR; PG8_WAIT_L(0); PG8_MMA(0, 1, At, B1); PG8_BAR;
            PG8_LDA(At, 0, 1); PG8_STAGEA(PG8_SA(0, 0), a2, voffA);
            PG8_BAR; PG8_WAIT_L(0); PG8_MMA(1, 0, At, B0); PG8_BAR; PG8_SCHED;
            PG8_STAGEB(PG8_SB(0, 1), b2 + hstepB, voffB);
            PG8_WAIT_V(6); PG8_BAR; PG8_MMA(1, 1, At, B1); PG8_BAR;
            PG8_LDB(B0, 1, 0); PG8_SCHED; PG8_LDA(At, 1, 0); PG8_STAGEA(PG8_SA(0, 1), a2 + hstepA, voffA);
            PG8_WAIT_L(8); PG8_BAR; PG8_WAIT_L(0); PG8_MMA(0, 0, At, B0); PG8_BAR; PG8_SCHED;
            PG8_LDB(B1, 1, 1); PG8_STAGEB(PG8_SB(1, 0), b3, voffB);
            PG8_BAR; PG8_WAIT_L(0); PG8_MMA(0, 1, At, B1); PG8_BAR;
            PG8_LDA(At, 1, 1); PG8_STAGEA(PG8_SA(1, 0), a3, voffA);
            PG8_BAR; PG8_WAIT_L(0); PG8_MMA(1, 0, At, B0); PG8_BAR; PG8_SCHED;
            PG8_STAGEB(PG8_SB(1, 1), b3 + hstepB, voffB);
            PG8_WAIT_V(6); PG8_BAR; PG8_MMA(1, 1, At, B1); PG8_BAR;
            }
        }
        if constexpr (ALIGN_EPI) { if (wr == 0) PG8_BAR; }
        if constexpr (!Epi::AFTER_DRAIN) { E(acc, cur, wr, wc, fr, fq); S.done(cur); }
        if (!has_next) break;
#pragma unroll
        for (int a = 0; a < 2; ++a)
#pragma unroll
            for (int b = 0; b < 2; ++b)
#pragma unroll
                for (int m = 0; m < 4; ++m)
#pragma unroll
                    for (int n = 0; n < 2; ++n) acc[a][b][m][n] = (f32x4){0.f, 0.f, 0.f, 0.f};
        cur = nxt; cA = nA; cB = nB; ++ui;
        if constexpr (ALIGN_EPI) { if (wr == 1) PG8_BAR; }
    }
    PG8_WAIT_V(0);
    if constexpr (!ALIGN_EPI) { if (wr == 0) PG8_BAR; }
    PG8_BAR;
    if constexpr (Epi::AFTER_DRAIN) { E.fused(acc, cur, wr, wc, fr, fq, lds, wid, lane); S.done(cur); }
#undef PG8_SA
#undef PG8_SB
#undef PG8_STAGEA
#undef PG8_STAGEB
#undef PG8_LDA
#undef PG8_LDB
#undef PG8_MMA
#undef PG8_WAIT_V
#undef PG8_WAIT_L
#undef PG8_BAR
#undef PG8_SCHED
}

}

struct QResidual {
    const float* xin_f32; float* xout_f32; bf16_t* xb; const float* bias; const float* scale; float* stat;
    const bf16_t* xsrc;
    struct Pre { f32x4 r[4]; };
    static constexpr bool HAS_RTAB = false;
    __device__ __forceinline__ Pre preload(int row, int pn, int cin) const {
        Pre o; const size_t off = (size_t)row * DM + 256 * pn + cin;
        if (xin_f32) { const float* p = xin_f32 + off; o.r[0] = *(const f32x4*)p; o.r[1] = *(const f32x4*)(p + 4); o.r[2] = *(const f32x4*)(p + 128); o.r[3] = *(const f32x4*)(p + 132); }
        else { const bf16_t* rs = xsrc ? xsrc : xb; const u32x4 h0 = *(const u32x4*)(rs + off), h1 = *(const u32x4*)(rs + off + 128);
            o.r[0] = (f32x4){bflo(h0[0]), bfhi(h0[0]), bflo(h0[1]), bfhi(h0[1])}; o.r[1] = (f32x4){bflo(h0[2]), bfhi(h0[2]), bflo(h0[3]), bfhi(h0[3])};
            o.r[2] = (f32x4){bflo(h1[0]), bfhi(h1[0]), bflo(h1[1]), bfhi(h1[1])}; o.r[3] = (f32x4){bflo(h1[2]), bfhi(h1[2]), bflo(h1[3]), bfhi(h1[3])}; }
        return o;
    }
    __device__ __forceinline__ float half(int row, int col, f32x4 v0, f32x4 v1, f32x4 r0, f32x4 r1) const {
        const size_t off = (size_t)row * DM + col;
        if (bias) {
            const f32x4 b0 = *(const f32x4*)(bias + col), b1 = *(const f32x4*)(bias + col + 4), s0 = *(const f32x4*)(scale + col), s1 = *(const f32x4*)(scale + col + 4);
            v0 = (v0 + b0) * s0; v1 = (v1 + b1) * s1;
        }
        v0 = v0 + r0; v1 = v1 + r1;
        if (xout_f32) { *(f32x4*)(xout_f32 + off) = v0; *(f32x4*)(xout_f32 + off + 4) = v1; }
        else *(u32x4*)(xb + off) = pack8(v0, v1);
        const f32x4 q0 = v0 * v0, q1 = v1 * v1; return ((q0.x + q0.y) + (q0.z + q0.w)) + ((q1.x + q1.y) + (q1.z + q1.w));
    }
    __device__ __forceinline__ float quad(int row, int pn, int cin, f32x4 a0, f32x4 a1, f32x4 b0, f32x4 b1, const Pre& p) const {
        return half(row, 256 * pn + cin, a0, a1, p.r[0], p.r[1]) + half(row, 256 * pn + 128 + cin, b0, b1, p.r[2], p.r[3]);
    }
    struct PreRaw { u32x4 h0, h1; };
    static constexpr bool DEEP = true;
    __device__ __forceinline__ bool deep_ok() const { return xin_f32 == nullptr; }
    __device__ __forceinline__ PreRaw preload_raw(int row, int pn, int cin) const {
        const size_t off = (size_t)row * DM + 256 * pn + cin; const bf16_t* rs = xsrc ? xsrc : xb;
        PreRaw o; o.h0 = *(const u32x4*)(rs + off); o.h1 = *(const u32x4*)(rs + off + 128); return o;
    }
    __device__ __forceinline__ float quad_raw(int row, int pn, int cin, f32x4 a0, f32x4 a1, f32x4 b0, f32x4 b1, const PreRaw& p) const {
        const u32x4 h0 = p.h0, h1 = p.h1;
        return half(row, 256 * pn + cin, a0, a1, (f32x4){bflo(h0[0]), bfhi(h0[0]), bflo(h0[1]), bfhi(h0[1])}, (f32x4){bflo(h0[2]), bfhi(h0[2]), bflo(h0[3]), bfhi(h0[3])})
             + half(row, 256 * pn + 128 + cin, b0, b1, (f32x4){bflo(h1[0]), bfhi(h1[0]), bflo(h1[1]), bfhi(h1[1])}, (f32x4){bflo(h1[2]), bfhi(h1[2]), bflo(h1[3]), bfhi(h1[3])});
    }
    __device__ __forceinline__ void put_stat(int row, int pn, float tot) const { stat[4 * (size_t)row + pn] = tot; }
};
typedef float f32x2 __attribute__((ext_vector_type(2)));
__device__ __forceinline__ f32x2 silu_mul2(f32x2 a, f32x2 b, float nr, float rr) {
    const f32x2 t = a * nr; f32x2 e; e.x = __builtin_amdgcn_exp2f(t.x); e.y = __builtin_amdgcn_exp2f(t.y);
    const f32x2 d = e + 1.0f; f32x2 rc; rc.x = __builtin_amdgcn_rcpf(d.x); rc.y = __builtin_amdgcn_rcpf(d.y);
    return (a * b) * (rc * rr);
}
struct QGateUp {
    bf16_t* hid; const float* stat;
    const LAS float* rtab; int tab_pm;
    static constexpr bool HAS_RTAB = true;
    __device__ __forceinline__ float rinv_global(int row) const { return row_rinv(stat, row, 1.0f / DM); }
    struct Pre { float r; };
    __device__ __forceinline__ Pre preload(int row, int, int) const { Pre o; o.r = (row >> 8) == tab_pm ? rtab[row & 255] : rinv_global(row); return o; }
    __device__ __forceinline__ float quad(int row, int pn, int cin, f32x4 a0, f32x4 a1, f32x4 b0, f32x4 b1, const Pre& pp) const {
        const float r = pp.r, nr = -1.4426950408889634f * r, rr = r * r;
        const f32x2 h00 = silu_mul2((f32x2){a0[0], a0[1]}, (f32x2){b0[0], b0[1]}, nr, rr), h01 = silu_mul2((f32x2){a0[2], a0[3]}, (f32x2){b0[2], b0[3]}, nr, rr);
        const f32x2 h10 = silu_mul2((f32x2){a1[0], a1[1]}, (f32x2){b1[0], b1[1]}, nr, rr), h11 = silu_mul2((f32x2){a1[2], a1[3]}, (f32x2){b1[2], b1[3]}, nr, rr);
        u32x4 w; w.x = cvt_pk_bf16(h00.x, h00.y); w.y = cvt_pk_bf16(h01.x, h01.y); w.z = cvt_pk_bf16(h10.x, h10.y); w.w = cvt_pk_bf16(h11.x, h11.y);
        *(u32x4*)(hid + (size_t)row * DFF + 128 * pn + cin) = w; return 0.f;
    }
};
constexpr size_t CKV_TSTEP = (size_t)256 * DFF, CKV_OFF = (size_t)256 * DM;
struct QKvd {
    bf16_t* ckvb; bf16_t* cqb; float* kpe; const float* stat; float* statc; float* statq; float* statpe;
    const LAS float* rtab; int tab_pm;
    static constexpr bool HAS_RTAB = true;
    __device__ __forceinline__ float rinv_global(int row) const { return row_rinv(stat, row, 1.0f / DM); }
    struct Pre { float r; };
    __device__ __forceinline__ Pre preload(int row, int, int) const { Pre o; o.r = (row >> 8) == tab_pm ? rtab[row & 255] : rinv_global(row); return o; }
    __device__ __forceinline__ float quad(int row, int pn, int cin, f32x4 a0, f32x4 a1, f32x4 b0, f32x4 b1, const Pre& pp) const {
        const float r = pp.r;
        a0 = a0 * r; a1 = a1 * r; b0 = b0 * r; b1 = b1 * r;
        if (pn < 2) { bf16_t* o = ckvb + (size_t)(row >> 8) * CKV_TSTEP + (size_t)(row & 255) * KVLR + 256 * pn + cin; *(u32x4*)o = pack8(a0, a1); *(u32x4*)(o + 128) = pack8(b0, b1); }
        else if (pn == 2) { bf16_t* o = cqb + (size_t)row * QLR + cin; *(u32x4*)o = pack8(a0, a1); *(u32x4*)(o + 128) = pack8(b0, b1); }
        else if (cin < DR) { float* o = kpe + (size_t)row * DR + cin; *(f32x4*)o = a0; *(f32x4*)(o + 4) = a1; }
        const f32x4 q0 = a0 * a0 + b0 * b0, q1 = a1 * a1 + b1 * b1; return ((q0.x + q0.y) + (q0.z + q0.w)) + ((q1.x + q1.y) + (q1.z + q1.w));
    }
    __device__ __forceinline__ void put_stat(int row, int pn, float tot) const {
        if (pn < 2) { statc[4 * (size_t)row + pn] = tot; statc[4 * (size_t)row + 2 + pn] = 0.f; }
        else if (pn == 2) *(f32x4*)(statq + 4 * (size_t)row) = (f32x4){tot, 0.f, 0.f, 0.f};
        else statpe[row] = tot;
    }
};
struct QRowScale {
    bf16_t* out; int ldc; const float* stat; float invn; float* stat_out;
    const LAS float* rtab; int tab_pm;
    static constexpr bool HAS_RTAB = true;
    __device__ __forceinline__ float rinv_global(int row) const { return row_rinv(stat, row, invn); }
    struct Pre { float r; };
    __device__ __forceinline__ Pre preload(int row, int, int) const { Pre o; o.r = (row >> 8) == tab_pm ? rtab[row & 255] : rinv_global(row); return o; }
    __device__ __forceinline__ float quad(int row, int pn, int cin, f32x4 a0, f32x4 a1, f32x4 b0, f32x4 b1, const Pre& pp) const {
        const float r = pp.r;
        bf16_t* o = out + (size_t)row * ldc + 256 * pn + cin;
        a0 = a0 * r; a1 = a1 * r; b0 = b0 * r; b1 = b1 * r;
        *(u32x4*)o = pack8(a0, a1); *(u32x4*)(o + 128) = pack8(b0, b1);
        const f32x4 q0 = a0 * a0 + b0 * b0, q1 = a1 * a1 + b1 * b1; return ((q0.x + q0.y) + (q0.z + q0.w)) + ((q1.x + q1.y) + (q1.z + q1.w));
    }
    __device__ __forceinline__ void put_stat(int row, int pn, float tot) const { if (stat_out) *(f32x4*)(stat_out + 4 * (size_t)row) = (f32x4){tot, 0.f, 0.f, 0.f}; }
};

constexpr int NWAVES = 8;
constexpr int RING_BYTES = 131072;
constexpr int KT_PITCH = 400, KT_BYTES = 64 * KT_PITCH, VT_PITCH = 320, VT_BYTES = 64 * VT_PITCH, KV_STAGE = KT_BYTES + VT_BYTES;
constexpr int WQI_HEAD = 32 * 192 * 16, WQ_OFF = KV_STAGE;
constexpr int ATT_OST = 2 * KV_STAGE, OST_PITCH = 264, OST_WAVE = 32 * OST_PITCH, ATT_LDS = ATT_OST + 8 * OST_WAVE;
constexpr int STATP_OFF = RING_BYTES;
constexpr int MISC_OFF = 159744 + 64, LDS_BYTES = 160 * 1024;
static_assert(ATT_LDS <= 159744 && MISC_OFF + 128 + 192 <= LDS_BYTES && STATP_OFF + 8192 <= MISC_OFF, "LDS map");
struct Frame {
    LAS unsigned char* lds; volatile LAS unsigned* MISC;
    int tid, lane, wave, vcu, G, gw, ngw;
};

enum { RM_PLAIN = 0, RM_GATE = 1, RM_UP = 2 };
__device__ __forceinline__ void prep_mat(const Frame& F, int& rot, const float* W, int ldsrc, int K, int ncols, int col0, const float* gain, bf16_t* WT, int mode, int row0) {
    LAS float* scr = (LAS float*)(F.lds + F.wave * 16384);
    const int lane = F.lane, nblk = ncols / 32, nitems = (K / 64) * nblk;
    const int first_ = (F.gw - rot + F.ngw) % F.ngw; rot = (rot + nitems) % F.ngw;
    for (int item = first_; item < nitems; item += F.ngw) {
        const int kb = item / nblk, nb = item % nblk, k0 = 64 * kb, n0 = 32 * nb;
        float v[32];
        const float* wp = W + (size_t)(k0 + (lane >> 5)) * ldsrc + col0 + n0 + (lane & 31);
#pragma unroll
        for (int i = 0; i < 32; ++i) v[i] = wp[(size_t)(2 * i) * ldsrc];
        if (gain) {
            const float* gp = gain + k0 + (lane >> 5);
#pragma unroll
            for (int i = 0; i < 32; ++i) v[i] *= gp[2 * i];
        }
#pragma unroll
        for (int i = 0; i < 32; ++i) scr[(2 * i + (lane >> 5)) * 33 + (lane & 31)] = v[i];
        asm volatile("s_waitcnt lgkmcnt(0)" ::: "memory");
        const int c = lane & 7;
#pragma unroll
        for (int j = 0; j < 4; ++j) { const int nl = (lane >> 3) + 8 * j, n = n0 + nl; const LAS float* s = scr + (8 * c) * 33 + nl;
            u32x4 o; o.x = cvt_pk_bf16(s[0 * 33], s[1 * 33]); o.y = cvt_pk_bf16(s[2 * 33], s[3 * 33]); o.z = cvt_pk_bf16(s[4 * 33], s[5 * 33]); o.w = cvt_pk_bf16(s[6 * 33], s[7 * 33]);
            const int drow = mode == RM_PLAIN ? row0 + n : (256 * (n >> 7) + (n & 127) + (mode == RM_UP ? 128 : 0));
            *(u32x4*)(WT + (size_t)drow * K + k0 + 8 * c) = o; }
        asm volatile("s_waitcnt lgkmcnt(0)" ::: "memory");
    }
}

__device__ __forceinline__ void rowstat_x(const Frame& F, const float* x, float* stat) {
    for (int r0 = 4 * F.gw; r0 < M; r0 += 4 * F.ngw) {
        f32x4 v[4][4];
#pragma unroll
        for (int i = 0; i < 4; ++i) { const f32x4* p = (const f32x4*)(x + (size_t)(r0 + i) * DM) + F.lane;
#pragma unroll
            for (int j = 0; j < 4; ++j) v[i][j] = p[64 * j]; }
#pragma unroll
        for (int i = 0; i < 4; ++i) { float s = 0.f;
#pragma unroll
            for (int j = 0; j < 4; ++j) s += (v[i][j].x * v[i][j].x + v[i][j].y * v[i][j].y) + (v[i][j].z * v[i][j].z + v[i][j].w * v[i][j].w);
            s = wave_sum(s);
            if (F.lane == 0) *(f32x4*)(stat + 4 * (size_t)(r0 + i)) = (f32x4){s, 0.f, 0.f, 0.f}; }
    }
}
__device__ __forceinline__ float ld_as_f32(const float* p) { return *p; }
__device__ __forceinline__ float ld_as_f32(const bf16_t* p) { return bf2f((unsigned)*p); }
template <int W, class T> __device__ __forceinline__ void pool_load(const T* x, float (&xv)[32 + W - 1], int t0, int c) {
    const int pos0 = t0 & (SEQ - 1);
    const T* xp = x + (size_t)(t0 - (W - 1)) * DM + c;
#pragma unroll
    for (int i = 0; i < 32 + W - 1; ++i) xv[i] = (pos0 - (W - 1) + i >= 0) ? ld_as_f32(xp + (size_t)i * DM) : 0.f;
}
template <int W> __device__ __forceinline__ void pool_finish(float (&xv)[32 + W - 1], const LAS float* rt, float gc, bf16_t* dout, int t0, int c) {
    const int pos0 = t0 & (SEQ - 1);
#pragma unroll
    for (int i = 0; i < 32 + W - 1; ++i) xv[i] *= rt[16 - W + i];
    float ws[32 + W - 1];
#pragma unroll
    for (int i = 0; i < 32 + W - 1; ++i) ws[i] = xv[i];
#pragma unroll
    for (int w = 1; w < W; w *= 2) {
#pragma unroll
        for (int i = 32 + W - 2; i >= 2 * w - 1; --i) ws[i] += ws[i - w];
    }
#pragma unroll
    for (int i = 0; i < 32; ++i) {
        const int pos = pos0 + i; const float v = xv[i + W - 1];
        const int cnt = pos + 1 < W ? pos + 1 : W;
        const float d = (ws[i + W - 1] * (1.0f / (float)cnt) - v) * gc;
        dout[(size_t)(t0 + i) * DM + c] = (bf16_t)(cvt_pk_bf16(d, 0.f) & 0xffffu);
    }
}
template <int W, class T> __device__ __forceinline__ void pool_thread2(const T* x, const LAS float* rtA, const LAS float* rtB, const float* gain, bf16_t* dout, int tA, int tB, int c) {
    const float gc = gain[c];
    float xa[32 + W - 1], xb[32 + W - 1];
    pool_load<W, T>(x, xa, tA, c); pool_load<W, T>(x, xb, tB, c);
    pool_finish<W>(xa, rtA, gc, dout, tA, c); pool_finish<W>(xb, rtB, gc, dout, tB, c);
}
template <class T> __device__ __forceinline__ void pool_prep_unit(const Frame& F, const T* x, const float* stat, const float* gain, bf16_t* dout, int pm, int g) {
    LAS float* rt = (LAS float*)(F.lds + STATP_OFF);
    __syncthreads();
    if (F.tid < 271) { const int t = pm * 256 - 15 + F.tid; rt[F.tid] = ((pm & 15) != 0 || F.tid >= 15) ? row_rinv(stat, t, 1.0f / DM) : 0.f; }
    asm volatile("s_waitcnt lgkmcnt(0)" ::: "memory"); __syncthreads();
    const int c = g * 256 + (F.tid & 255);
#pragma unroll 1
    for (int q = 0; q < 2; ++q) {
        const int chA = 4 * q + (F.tid >> 8), chB = chA + 2, tA = pm * 256 + chA * 32, tB = pm * 256 + chB * 32; const LAS float* rA = rt + chA * 32; const LAS float* rB = rt + chB * 32;
        if (g == 0) pool_thread2<2, T>(x, rA, rB, gain, dout, tA, tB, c);
        else if (g == 1) pool_thread2<4, T>(x, rA, rB, gain, dout, tA, tB, c);
        else if (g == 2) pool_thread2<8, T>(x, rA, rB, gain, dout, tA, tB, c);
        else pool_thread2<16, T>(x, rA, rB, gain, dout, tA, tB, c);
    }
}

__device__ __forceinline__ void rope_cs(int pos, int i, float& c, float& s) {
    const float inv = __builtin_amdgcn_exp2f(-(float)i * 0.41524101186092f);
    const float ang = (float)pos * inv;
    const float n = rintf(ang * 0.15915494309189535f);
    float r = fmaf(-n, 6.2831854820251465f, ang); r = fmaf(-n, -1.7484556000744883e-07f, r);
    const float rv = r * 0.15915494309189535f;
    c = __builtin_amdgcn_cosf(rv); s = __builtin_amdgcn_sinf(rv);
}

__device__ __forceinline__ void finalize_q(const Frame& F, bf16_t* q, const float* g_q, const int* positions) {
    LAS float* scr = (LAS float*)(F.lds + F.wave * 16384); const int l = F.lane;
    for (int t = F.gw; t < M; t += F.ngw) {
        const int pos = positions[t];
        bf16_t* row = q + (size_t)t * (NH * DQK) + 24 * l;
        const u32x4 w0 = *(const u32x4*)row, w1 = *(const u32x4*)(row + 8), w2 = *(const u32x4*)(row + 16);
        float v[24];
#pragma unroll
        for (int i = 0; i < 4; ++i) { v[2 * i] = bflo(w0[i]); v[2 * i + 1] = bfhi(w0[i]); v[8 + 2 * i] = bflo(w1[i]); v[8 + 2 * i + 1] = bfhi(w1[i]); v[16 + 2 * i] = bflo(w2[i]); v[16 + 2 * i + 1] = bfhi(w2[i]); }
        float ss = 0.f;
#pragma unroll
        for (int i = 0; i < 24; ++i) ss += v[i] * v[i];
        ss += xshfl<1>(ss); ss += xshfl<2>(ss); ss += xshfl<4>(ss);
        const float rq = rsqrtf(ss * (1.0f / DQK) + EPS) * QSCALE;
        const int c0 = 24 * (l & 7);
#pragma unroll
        for (int i = 0; i < 24; ++i) scr[24 * l + i] = v[i] * rq * g_q[c0 + i];
        asm volatile("s_waitcnt lgkmcnt(0)" ::: "memory");
        const int i = l & 31; float c, sn; rope_cs(pos, i, c, sn);
#pragma unroll
        for (int p = 0; p < 4; ++p) { const int pid = l + 64 * p, h = pid >> 5; LAS float* a = scr + DQK * h + DN + i; const float x1 = a[0], x2 = a[32];
            a[0] = x1 * c - x2 * sn; a[32] = x2 * c + x1 * sn; }
        asm volatile("s_waitcnt lgkmcnt(0)" ::: "memory");
        f32x4 o[6];
#pragma unroll
        for (int k = 0; k < 6; ++k) o[k] = *(const LAS f32x4*)(scr + 24 * l + 4 * k);
        *(u32x4*)row = pack8(o[0], o[1]); *(u32x4*)(row + 8) = pack8(o[2], o[3]); *(u32x4*)(row + 16) = pack8(o[4], o[5]);
        asm volatile("s_waitcnt lgkmcnt(0)" ::: "memory");
    }
}

__device__ __forceinline__ int crow(int r, int hi) { return (r & 3) + 8 * (r >> 2) + 4 * hi; }
__device__ __forceinline__ void attn_simple_unit(const bf16_t* Q, const bf16_t* Kf, const bf16_t* Vt, bf16_t* O, int bh, int qw, int lane) {
    const int c = lane & 31, hi = lane >> 5, b = bh / NH, h = bh % NH;
    const bf16_t* qp = Q + (size_t)(b * SEQ + 32 * qw + c) * (NH * DQK) + h * DQK + 8 * hi;
    bf16x8 qf[12];
#pragma unroll
    for (int st = 0; st < 12; ++st) qf[st] = *(const bf16x8*)(qp + 16 * st);
    f32x16 o[4];
#pragma unroll
    for (int d = 0; d < 4; ++d) o[d] = (f32x16){};
    float m = -1e30f, lsum = 0.f;
    const int nkb = 2 * ((qw >> 1) + 1);
    const bf16_t* kbase = Kf + (size_t)bh * SEQ * (KT_PITCH / 2) + (size_t)c * (KT_PITCH / 2) + 8 * hi;
    const bf16_t* vbase = Vt + (size_t)bh * SEQ * (VT_PITCH / 2) + c;
    for (int kb = 0; kb < nkb; ++kb) {
        f32x16 sacc = (f32x16){};
        const bf16_t* kp = kbase + (size_t)(32 * kb) * (KT_PITCH / 2);
#pragma unroll
        for (int st = 0; st < 12; ++st) { const bf16x8 kf = *(const bf16x8*)(kp + 16 * st); sacc = __builtin_amdgcn_mfma_f32_32x32x16_bf16(kf, qf[st], sacc, 0, 0, 0); }
        float mx = sacc[0];
#pragma unroll
        for (int r = 1; r < 16; ++r) mx = fmaxf(mx, sacc[r]);
        mx = max32(mx);
        const float mn = fmaxf(m, mx), alpha = __builtin_amdgcn_exp2f(m - mn);
        float ps = 0.f;
#pragma unroll
        for (int r = 0; r < 16; ++r) { sacc[r] = __builtin_amdgcn_exp2f(sacc[r] - mn); ps += sacc[r]; }
        ps = sum32(ps);
        lsum = lsum * alpha + ps; m = mn;
#pragma unroll
        for (int d = 0; d < 4; ++d)
#pragma unroll
            for (int r = 0; r < 16; ++r) o[d][r] *= alpha;
        bf16x8 pb[2];
#pragma unroll
        for (int s2 = 0; s2 < 2; ++s2) { u32x4 w; w.x = cvt_pk_bf16(sacc[8 * s2 + 0], sacc[8 * s2 + 1]); w.y = cvt_pk_bf16(sacc[8 * s2 + 2], sacc[8 * s2 + 3]); w.z = cvt_pk_bf16(sacc[8 * s2 + 4], sacc[8 * s2 + 5]); w.w = cvt_pk_bf16(sacc[8 * s2 + 6], sacc[8 * s2 + 7]);
            pb[s2] = __builtin_bit_cast(bf16x8, w); }
#pragma unroll
        for (int d = 0; d < 4; ++d)
#pragma unroll
            for (int s2 = 0; s2 < 2; ++s2) { bf16x8 vf;
#pragma unroll
                for (int j = 0; j < 8; ++j) vf[j] = (short)vbase[(size_t)(32 * kb + 16 * s2 + 8 * (j >> 2) + 4 * hi + (j & 3)) * (VT_PITCH / 2) + 32 * d];
                o[d] = __builtin_amdgcn_mfma_f32_32x32x16_bf16(vf, pb[s2], o[d], 0, 0, 0); }
    }
    const float rl = 1.0f / lsum;
    bf16_t* op = O + (size_t)(b * SEQ + 32 * qw + c) * DM + h * DV;
#pragma unroll
    for (int d = 0; d < 4; ++d)
#pragma unroll
        for (int g = 0; g < 4; ++g) { u32x2 w; w.x = cvt_pk_bf16(o[d][4 * g] * rl, o[d][4 * g + 1] * rl); w.y = cvt_pk_bf16(o[d][4 * g + 2] * rl, o[d][4 * g + 3] * rl);
            *(u32x2*)(op + 32 * d + 8 * g + 4 * hi) = w; }
}
__device__ __forceinline__ void attn_simple(const Frame& F, const bf16_t* Q, const bf16_t* Kf, const bf16_t* Vt, bf16_t* O) {
    for (int w = F.gw; w < BATCH * NH * 64; w += F.ngw) {
        const int bh = w >> 6, i = w & 63;
        attn_simple_unit(Q, Kf, Vt, O, bh, 127 - i, F.lane);
        attn_simple_unit(Q, Kf, Vt, O, bh, i, F.lane);
    }
}

__device__ __forceinline__ void prep_wqimg(const Frame& F, const bf16_t* wuq_t, bf16_t* wqi) {
    for (int e = F.gw * 64 + F.lane; e < 2 * NH * 32 * 192; e += F.ngw * 64) {
        const int ip = e % 192, kc = (e / 192) % 32, jh = e / (192 * 32), i = ip & 31, b6 = ip >> 5;
        const int dim = 32 * b6 + 16 * (i >> 4) + 8 * ((i >> 2) & 1) + 4 * ((i >> 3) & 1) + (i & 3);
        *(u32x4*)(wqi + (size_t)e * 8) = *(const u32x4*)(wuq_t + ((size_t)jh * 192 + dim) * QLR + 8 * kc);
    }
}
constexpr float ATT_BMAX = 48.0f;
constexpr size_t OSLOT_ELEMS = (size_t)256 * DFF;
#define ATT_MAP16 true
#define ATT_DESC2 true
#define ATT_SB() __builtin_amdgcn_sched_barrier(0)
typedef short s16x4_t __attribute__((ext_vector_type(4)));
typedef short v4i16_t __attribute__((ext_vector_type(4)));
__device__ __forceinline__ void attn_qk(const LAS unsigned char* kb, const bf16x8 (&qf)[12], bf16x8 (&pb)[4], float& lsum) {
    f32x16 p0, p1;
    bf16x8 ka[2][2];
#define ATT_KLD(bf, st) do { ka[bf][0] = *(const LAS bf16x8*)(kb + (st) * 32); ka[bf][1] = *(const LAS bf16x8*)(kb + 32 * KT_PITCH + (st) * 32); } while (0)
    ATT_KLD(0, 0); ATT_SB();
#pragma unroll
    for (int st = 0; st < 12; ++st) {
        if (st < 11) ATT_KLD((st + 1) & 1, st + 1);
        __builtin_amdgcn_s_setprio(1);
        if (st == 0) { p0 = __builtin_amdgcn_mfma_f32_32x32x16_bf16(ka[0][0], qf[0], (f32x16){}, 0, 0, 0); p1 = __builtin_amdgcn_mfma_f32_32x32x16_bf16(ka[0][1], qf[0], (f32x16){}, 0, 0, 0); }
        else { p0 = __builtin_amdgcn_mfma_f32_32x32x16_bf16(ka[st & 1][0], qf[st], p0, 0, 0, 0); p1 = __builtin_amdgcn_mfma_f32_32x32x16_bf16(ka[st & 1][1], qf[st], p1, 0, 0, 0); }
        __builtin_amdgcn_s_setprio(0);
        ATT_SB();
    }
#undef ATT_KLD
    float sa = 0.f, sb = 0.f;
#pragma unroll
    for (int r = 0; r < 16; ++r) { p0[r] = __builtin_amdgcn_exp2f(p0[r]); p1[r] = __builtin_amdgcn_exp2f(p1[r]); sa += p0[r]; sb += p1[r]; }
    lsum += sa + sb;
#pragma unroll
    for (int s2 = 0; s2 < 2; ++s2) {
        u32x4 w; w.x = cvt_pk_bf16(p0[8 * s2 + 0], p0[8 * s2 + 1]); w.y = cvt_pk_bf16(p0[8 * s2 + 2], p0[8 * s2 + 3]); w.z = cvt_pk_bf16(p0[8 * s2 + 4], p0[8 * s2 + 5]); w.w = cvt_pk_bf16(p0[8 * s2 + 6], p0[8 * s2 + 7]);
        pb[s2] = __builtin_bit_cast(bf16x8, w);
        u32x4 v; v.x = cvt_pk_bf16(p1[8 * s2 + 0], p1[8 * s2 + 1]); v.y = cvt_pk_bf16(p1[8 * s2 + 2], p1[8 * s2 + 3]); v.z = cvt_pk_bf16(p1[8 * s2 + 4], p1[8 * s2 + 5]); v.w = cvt_pk_bf16(p1[8 * s2 + 6], p1[8 * s2 + 7]);
        pb[2 + s2] = __builtin_bit_cast(bf16x8, v);
    }
}
__device__ __forceinline__ void attn_pv(const LAS unsigned char* vb, const bf16x8 (&pb)[4], f32x16 (&o)[4]) {
    const unsigned va_ = (unsigned)(size_t)vb;
    s16x4_t r[2][4];
#define ATT_TRR(dst, off) asm volatile("ds_read_b64_tr_b16 %0, %1 offset:%2" : "=v"(dst) : "v"(va_), "i"(off))
#define ATT_VLD(bf, c) do { ATT_TRR(r[bf][0], (32 * ((c) & 1)) * VT_PITCH + ((c) >> 1) * 64); ATT_TRR(r[bf][1], (32 * ((c) & 1) + 8) * VT_PITCH + ((c) >> 1) * 64); \
                            ATT_TRR(r[bf][2], (32 * ((c) & 1) + 16) * VT_PITCH + ((c) >> 1) * 64); ATT_TRR(r[bf][3], (32 * ((c) & 1) + 24) * VT_PITCH + ((c) >> 1) * 64); } while (0)
    ATT_VLD(0, 0);
#pragma unroll
    for (int cidx = 0; cidx < 8; ++cidx) {
        if (cidx < 7) { ATT_VLD((cidx + 1) & 1, cidx + 1); asm volatile("s_waitcnt lgkmcnt(4)" : "+v"(r[cidx & 1][0]), "+v"(r[cidx & 1][1]), "+v"(r[cidx & 1][2]), "+v"(r[cidx & 1][3])); }
        else asm volatile("s_waitcnt lgkmcnt(0)" : "+v"(r[cidx & 1][0]), "+v"(r[cidx & 1][1]), "+v"(r[cidx & 1][2]), "+v"(r[cidx & 1][3]));
        ATT_SB();
        const bf16x8 f0 = __builtin_shufflevector(r[cidx & 1][0], r[cidx & 1][1], 0, 1, 2, 3, 4, 5, 6, 7), f1 = __builtin_shufflevector(r[cidx & 1][2], r[cidx & 1][3], 0, 1, 2, 3, 4, 5, 6, 7);
        __builtin_amdgcn_s_setprio(1);
        o[cidx >> 1] = __builtin_amdgcn_mfma_f32_32x32x16_bf16(f0, pb[2 * (cidx & 1)], o[cidx >> 1], 0, 0, 0);
        o[cidx >> 1] = __builtin_amdgcn_mfma_f32_32x32x16_bf16(f1, pb[2 * (cidx & 1) + 1], o[cidx >> 1], 0, 0, 0);
        __builtin_amdgcn_s_setprio(0);
        ATT_SB();
    }
#undef ATT_VLD
#undef ATT_TRR
}

__device__ __forceinline__ void attn_tile(const LAS unsigned char* kb, const LAS unsigned char* vb, const bf16x8 (&qf)[12], f32x16 (&o)[4], float& lsum) {
    f32x16 p0, p1;
    bf16x8 ka[2];
    f32x2 s2acc = {0.f, 0.f};
    u32x4 pw[4];
#define ATT_KLD(bf, half, st) ka[bf] = *(const LAS bf16x8*)(kb + (half) * 32 * KT_PITCH + (st) * 32)
    ATT_KLD(0, 0, 0); ATT_SB();
#pragma unroll
    for (int st = 0; st < 12; ++st) {
        if (st < 11) ATT_KLD((st + 1) & 1, 0, st + 1); else ATT_KLD(0, 1, 0);
        if (st == 0) p0 = __builtin_amdgcn_mfma_f32_32x32x16_bf16(ka[0], qf[0], (f32x16){}, 0, 0, 0); else p0 = __builtin_amdgcn_mfma_f32_32x32x16_bf16(ka[st & 1], qf[st], p0, 0, 0, 0);
        ATT_SB();
    }
#pragma unroll
    for (int st = 0; st < 12; ++st) {
        if (st < 11) ATT_KLD((st + 1) & 1, 1, st + 1);
        if (st == 0) p1 = __builtin_amdgcn_mfma_f32_32x32x16_bf16(ka[0], qf[0], (f32x16){}, 0, 0, 0); else p1 = __builtin_amdgcn_mfma_f32_32x32x16_bf16(ka[st & 1], qf[st], p1, 0, 0, 0);
        ATT_SB();
        if (st < 8) { p0[2 * st] = __builtin_amdgcn_exp2f(p0[2 * st]); p0[2 * st + 1] = __builtin_amdgcn_exp2f(p0[2 * st + 1]); }
        else { const int j_ = st - 8, b_ = 4 * j_; s2acc += (f32x2){p0[b_], p0[b_ + 1]}; s2acc += (f32x2){p0[b_ + 2], p0[b_ + 3]};
            pw[j_ >> 1][2 * (j_ & 1)] = cvt_pk_bf16(p0[b_], p0[b_ + 1]); pw[j_ >> 1][2 * (j_ & 1) + 1] = cvt_pk_bf16(p0[b_ + 2], p0[b_ + 3]); }
        ATT_SB();
    }
#undef ATT_KLD
    const unsigned va_ = (unsigned)(size_t)vb;
    s16x4_t r[2][4];
#define ATT_TRR(dst, off) asm volatile("ds_read_b64_tr_b16 %0, %1 offset:%2" : "=v"(dst) : "v"(va_), "i"(off))
#define ATT_VLD(bf, c) do { ATT_TRR(r[bf][0], (32 * ((c) & 1)) * VT_PITCH + ((c) >> 1) * 64); ATT_TRR(r[bf][1], (32 * ((c) & 1) + 8) * VT_PITCH + ((c) >> 1) * 64); \
                            ATT_TRR(r[bf][2], (32 * ((c) & 1) + 16) * VT_PITCH + ((c) >> 1) * 64); ATT_TRR(r[bf][3], (32 * ((c) & 1) + 24) * VT_PITCH + ((c) >> 1) * 64); } while (0)
#define ATT_CH(i) (2 * ((i) & 3) + ((i) >> 2))
    ATT_VLD(0, ATT_CH(0));
#pragma unroll
    for (int i = 0; i < 8; ++i) {
        const int cidx = ATT_CH(i);
        if (i < 7) { ATT_VLD((i + 1) & 1, ATT_CH(i + 1)); asm volatile("s_waitcnt lgkmcnt(4)" : "+v"(r[i & 1][0]), "+v"(r[i & 1][1]), "+v"(r[i & 1][2]), "+v"(r[i & 1][3])); }
        else asm volatile("s_waitcnt lgkmcnt(0)" : "+v"(r[i & 1][0]), "+v"(r[i & 1][1]), "+v"(r[i & 1][2]), "+v"(r[i & 1][3]));
        ATT_SB();
        const bf16x8 f0 = __builtin_shufflevector(r[i & 1][0], r[i & 1][1], 0, 1, 2, 3, 4, 5, 6, 7), f1 = __builtin_shufflevector(r[i & 1][2], r[i & 1][3], 0, 1, 2, 3, 4, 5, 6, 7);
        o[cidx >> 1] = __builtin_amdgcn_mfma_f32_32x32x16_bf16(f0, __builtin_bit_cast(bf16x8, pw[2 * (cidx & 1)]), o[cidx >> 1], 0, 0, 0);
        ATT_SB();
        if (i < 4) { p1[4 * i] = __builtin_amdgcn_exp2f(p1[4 * i]); p1[4 * i + 1] = __builtin_amdgcn_exp2f(p1[4 * i + 1]); ATT_SB(); }
        o[cidx >> 1] = __builtin_amdgcn_mfma_f32_32x32x16_bf16(f1, __builtin_bit_cast(bf16x8, pw[2 * (cidx & 1) + 1]), o[cidx >> 1], 0, 0, 0);
        ATT_SB();
        if (i < 4) { p1[4 * i + 2] = __builtin_amdgcn_exp2f(p1[4 * i + 2]); p1[4 * i + 3] = __builtin_amdgcn_exp2f(p1[4 * i + 3]); ATT_SB(); }
        if (i == 3) {
#pragma unroll
            for (int j_ = 0; j_ < 4; ++j_) { const int b_ = 4 * j_; s2acc += (f32x2){p1[b_], p1[b_ + 1]}; s2acc += (f32x2){p1[b_ + 2], p1[b_ + 3]};
                pw[2 + (j_ >> 1)][2 * (j_ & 1)] = cvt_pk_bf16(p1[b_], p1[b_ + 1]); pw[2 + (j_ >> 1)][2 * (j_ & 1) + 1] = cvt_pk_bf16(p1[b_ + 2], p1[b_ + 3]); }
            ATT_SB();
        }
    }
#undef ATT_CH
#undef ATT_VLD
#undef ATT_TRR
    lsum += s2acc.x + s2acc.y;
}
__device__ __forceinline__ void attn_dma_k(LAS unsigned char* lds, const bf16_t* kimg, int bh, int tile, int stage, int wid, int lane) {
    const __amdgpu_buffer_rsrc_t rs = __builtin_amdgcn_make_buffer_rsrc((void*)kimg, 0, 0x7ffffffc, 0x00020000);
    const unsigned so = (unsigned)(bh * (SEQ / 64) + tile) * (unsigned)KT_BYTES;
    LAS unsigned char* kd = lds + stage * KV_STAGE;
    for (int pc = wid; pc < KT_BYTES / 1024; pc += 8) __builtin_amdgcn_raw_ptr_buffer_load_lds(rs, (LAS void*)(kd + pc * 1024), 16, lane * 16, so + pc * 1024, 0, 0);
}
__device__ __forceinline__ void attn_dma_v(LAS unsigned char* lds, const bf16_t* vimg, int bh, int tile, int stage, int wid, int lane) {
    const __amdgpu_buffer_rsrc_t rs = __builtin_amdgcn_make_buffer_rsrc((void*)vimg, 0, 0x7ffffffc, 0x00020000);
    const unsigned so = (unsigned)(bh * (SEQ / 64) + tile) * (unsigned)VT_BYTES;
    LAS unsigned char* vd = lds + stage * KV_STAGE + KT_BYTES;
    for (int pc = 7 - wid; pc < VT_BYTES / 1024; pc += 8) __builtin_amdgcn_raw_ptr_buffer_load_lds(rs, (LAS void*)(vd + pc * 1024), 16, lane * 16, so + pc * 1024, 0, 0);
}
__device__ __forceinline__ void attn_wait_vm(int n) {
    if (n == 0) asm volatile("s_waitcnt vmcnt(0)" ::: "memory"); else if (n == 1) asm volatile("s_waitcnt vmcnt(1)" ::: "memory"); else if (n == 2) asm volatile("s_waitcnt vmcnt(2)" ::: "memory");
    else if (n == 3) asm volatile("s_waitcnt vmcnt(3)" ::: "memory"); else asm volatile("s_waitcnt vmcnt(4)" ::: "memory");
}
__device__ __forceinline__ void attn_unit(const Frame& F, const bf16_t* cq, const float* statq, const bf16_t* wqi, const bf16_t* kimg, const bf16_t* vimg, bf16_t* O, const float* g_q, const int* positions, int bh, int qb, bool desc) {
    int lane_ = F.lane; asm volatile("" : "+v"(lane_));
    const int lane = lane_, wid = F.wave, c = lane & 31, hi = lane >> 5, b = bh / NH, h = bh % NH;
    const int NT = 4 * qb + 4, tmax = 4 * qb + (wid >> 1);
    __builtin_amdgcn_s_barrier();
    const int t0 = desc ? NT - 1 : 0, dt = desc ? -1 : 1;
    attn_dma_k(F.lds, kimg, bh, t0, 0, wid, lane); attn_dma_v(F.lds, vimg, bh, t0, 0, wid, lane);
    {
        const __amdgpu_buffer_rsrc_t rs = __builtin_amdgcn_make_buffer_rsrc((void*)wqi, 0, 0x7ffffffc, 0x00020000); LAS unsigned char* wd = F.lds + WQ_OFF;
        for (int pc = wid; pc < WQI_HEAD / 1024; pc += 8) __builtin_amdgcn_raw_ptr_buffer_load_lds(rs, (LAS void*)(wd + pc * 1024), 16, lane * 16, (unsigned)h * WQI_HEAD + pc * 1024, 0, 0);
    }
    bf16x8 qf[12];
    {
        const int row = b * SEQ + 256 * qb + 32 * wid + c;
        const bf16_t* cp = cq + (size_t)row * QLR + 8 * hi;
        bf16x8 cf[16];
#pragma unroll
        for (int ks = 0; ks < 16; ++ks) cf[ks] = *(const bf16x8*)(cp + 16 * ks);
        const float rlat = row_rinv(statq, row, 1.0f / QLR);
        const int pos = positions[row];
        int hir = hi; asm volatile("" : "+v"(hir));
        asm volatile("s_waitcnt vmcnt(0)" ::: "memory"); __builtin_amdgcn_s_barrier(); asm volatile("" ::: "memory");
        f32x16 qa[6];
#pragma unroll
        for (int b6 = 0; b6 < 6; ++b6) qa[b6] = (f32x16){};
        const LAS unsigned char* wl = F.lds + WQ_OFF + (hi * 192 + c) * 16;
#pragma unroll
        for (int ks = 0; ks < 16; ++ks) {
            bf16x8 wa[6];
#pragma unroll
            for (int b6 = 0; b6 < 6; ++b6) wa[b6] = *(const LAS bf16x8*)(wl + (2 * ks * 192 + 32 * b6) * 16);
#pragma unroll
            for (int b6 = 0; b6 < 6; ++b6) qa[b6] = __builtin_amdgcn_mfma_f32_32x32x16_bf16(wa[b6], cf[ks], qa[b6], 0, 0, 0);
            __builtin_amdgcn_sched_barrier(0);
        }
        float ss = 0.f;
#pragma unroll
        for (int b6 = 0; b6 < 6; ++b6)
#pragma unroll
            for (int r = 0; r < 16; ++r) ss += qa[b6][r] * qa[b6][r];
        { const auto rr = __builtin_amdgcn_permlane32_swap(__float_as_uint(ss), __float_as_uint(ss), false, false); ss = __uint_as_float(rr[0]) + __uint_as_float(rr[1]); }
        const float rq = rlat * rsqrtf(ss * (rlat * rlat * (1.0f / DQK)) + EPS) * QSCALE;
        const float* gq = g_q + 8 * hir;
#pragma unroll
        for (int st = 0; st < 8; ++st) { const f32x4 g0 = *(const f32x4*)(gq + 16 * st), g1 = *(const f32x4*)(gq + 16 * st + 4); const int o8 = 8 * (st & 1);
            const f32x4 v0 = {qa[st >> 1][o8 + 0], qa[st >> 1][o8 + 1], qa[st >> 1][o8 + 2], qa[st >> 1][o8 + 3]}, v1 = {qa[st >> 1][o8 + 4], qa[st >> 1][o8 + 5], qa[st >> 1][o8 + 6], qa[st >> 1][o8 + 7]};
            qf[st] = __builtin_bit_cast(bf16x8, pack8(v0 * g0 * rq, v1 * g1 * rq)); }
#pragma unroll
        for (int st = 8; st < 10; ++st) {
            float xa[8], xb2[8];
#pragma unroll
            for (int e = 0; e < 8; ++e) { xa[e] = qa[4][8 * (st & 1) + e]; xb2[e] = qa[5][8 * (st & 1) + e]; }
            f32x4 oa[2], ob[2];
#pragma unroll
            for (int e = 0; e < 8; ++e) {
                const int i = 16 * (st - 8) + 8 * hir + e; float cs, sn; rope_cs(pos, i, cs, sn);
                const float x1 = xa[e] * rq * gq[16 * st + e], x2 = xb2[e] * rq * gq[16 * (st + 2) + e];
                oa[e >> 2][e & 3] = x1 * cs - x2 * sn; ob[e >> 2][e & 3] = x2 * cs + x1 * sn;
            }
            qf[st] = __builtin_bit_cast(bf16x8, pack8(oa[0], oa[1])); qf[st + 2] = __builtin_bit_cast(bf16x8, pack8(ob[0], ob[1]));
            __builtin_amdgcn_sched_barrier(0);
        }
    }
    __builtin_amdgcn_sched_barrier(0);
    f32x16 o[4];
#pragma unroll
    for (int d = 0; d < 4; ++d) o[d] = (f32x16){};
    float lsum = 0.f;
    const int kro = c * KT_PITCH + hi * 16, vro = KT_BYTES + (4 * hi + ((lane & 15) >> 2)) * VT_PITCH + 32 * ((lane >> 4) & 1) + 8 * (lane & 3);
    for (int i = 0; i < NT; ++i) {
        const int t = t0 + dt * i;
        asm volatile("s_waitcnt vmcnt(0)" ::: "memory"); __builtin_amdgcn_s_barrier(); asm volatile("" ::: "memory");
        if (i + 1 < NT) { attn_dma_k(F.lds, kimg, bh, t + dt, (i + 1) & 1, wid, lane); attn_dma_v(F.lds, vimg, bh, t + dt, (i + 1) & 1, wid, lane); }
        if (t <= tmax) {
            const LAS unsigned char* sb = F.lds + (i & 1) * KV_STAGE;
            attn_tile(sb + kro, sb + vro, qf, o, lsum);
        }
    }
    { const auto rr = __builtin_amdgcn_permlane32_swap(__float_as_uint(lsum), __float_as_uint(lsum), false, false); lsum = __uint_as_float(rr[0]) + __uint_as_float(rr[1]); }
    const float rl = 1.0f / lsum;
    LAS unsigned char* stg = F.lds + ATT_OST + wid * OST_WAVE;
#pragma unroll
    for (int d = 0; d < 4; ++d)
#pragma unroll
        for (int g = 0; g < 4; ++g) { u32x2 w; w.x = cvt_pk_bf16(o[d][4 * g] * rl, o[d][4 * g + 1] * rl); w.y = cvt_pk_bf16(o[d][4 * g + 2] * rl, o[d][4 * g + 3] * rl);
            *(LAS u32x2*)(stg + c * OST_PITCH + (32 * d + 8 * g + 4 * hi) * 2) = w; }
    asm volatile("s_waitcnt lgkmcnt(0)" ::: "memory");
    bf16_t* op = O + (size_t)(b * 16 + qb) * OSLOT_ELEMS + (size_t)(32 * wid) * DM + h * DV;
#pragma unroll
    for (int it = 0; it < 8; ++it) { const int row = 4 * it + (lane >> 4), ch = lane & 15; const u32x4 v = *(const LAS u32x4*)(stg + row * OST_PITCH + ch * 16); *(u32x4*)(op + (size_t)row * DM + ch * 8) = v; }
    asm volatile("s_waitcnt lgkmcnt(0)" ::: "memory");
}
__device__ __forceinline__ void attn_tiled(const Frame& F, const bf16_t* cq, const float* statq, const bf16_t* wqi, const bf16_t* kimg, const bf16_t* vimg, bf16_t* O, const float* g_q, const int* positions) {
    if (F.G == 256 && ATT_MAP16) {
        const int x = F.vcu >> 5, u = F.vcu & 31, g = u >> 4, qq = u & 15;
        attn_unit(F, cq, statq, wqi, kimg, vimg, O, g_q, positions, 4 * x + g, qq, false);
        attn_unit(F, cq, statq, wqi, kimg, vimg, O, g_q, positions, 4 * x + 2 + g, 15 - qq, true);
        return;
    }
    for (int i = F.vcu * 2; i < BATCH * NH * 16; i += F.G * 2)
        for (int k = 0; k < 2; ++k) { const int v = i >> 1, bh = v >> 3, s = v & 7; attn_unit(F, cq, statq, wqi, kimg, vimg, O, g_q, positions, bh, k == 0 ? 15 - s : s, ATT_DESC2 && k == 1); }
}
__device__ __forceinline__ float attn_logit_bound(const float* g_q, const float* g_k, int lane) {
    float mq = 0.f, mk = 0.f;
#pragma unroll
    for (int i = 0; i < 3; ++i) { mq = fmaxf(mq, fabsf(g_q[lane + 64 * i])); mk = fmaxf(mk, fabsf(g_k[lane + 64 * i])); }
    mq = fmaxf(mq, xshfl<1>(mq)); mq = fmaxf(mq, xshfl<2>(mq)); mq = fmaxf(mq, xshfl<4>(mq)); mq = fmaxf(mq, xshfl<8>(mq)); mq = fmaxf(mq, xshfl<16>(mq)); mq = max32(mq);
    mk = fmaxf(mk, xshfl<1>(mk)); mk = fmaxf(mk, xshfl<2>(mk)); mk = fmaxf(mk, xshfl<4>(mk)); mk = fmaxf(mk, xshfl<8>(mk)); mk = fmaxf(mk, xshfl<16>(mk)); mk = max32(mk);
    return 13.856406460551018f * 1.4426950408889634f * mq * mk;
}
template <class BarFn, class QuFn>
__device__ __forceinline__ void attn_phase(const Frame& F, bf16_t* Q, const bf16_t* cq, const float* statq, const bf16_t* wqi, const bf16_t* kimg, const bf16_t* vimg, bf16_t* O_slots, bf16_t* O, const float* g_q, const float* g_k,
                                           const int* positions, const BarFn& grid_bar, const QuFn& qu_gemm) {
    const float B = attn_logit_bound(g_q, g_k, F.lane);
    const bool tiled = __builtin_amdgcn_readfirstlane(B <= ATT_BMAX ? 1 : 0) != 0;
    if (F.tid == 0) F.MISC[24] = tiled ? 1u : 0u;
    if (tiled) attn_tiled(F, cq, statq, wqi, kimg, vimg, O_slots, g_q, positions);
    else { qu_gemm(); grid_bar(); finalize_q(F, Q, g_q, positions); grid_bar(); attn_simple(F, Q, kimg, vimg, O); }
}

struct EpiKvu {
    static constexpr bool PERM = true, AFTER_DRAIN = false;
    bf16_t* kimg; bf16_t* vimg; const float* statc; const float* statpe; const float* kpe; const float* g_k; const int* positions; LAS float* P; int tid;
    __device__ __forceinline__ void operator()(const f32x4 (&acc)[2][2][4][2], const pg8::Unit& u, int wr, int wc, int fr, int fq) const {
        const int ln = lane_now(); fr = ln & 15; fq = ln >> 4;
        const int cin = wc * 32 + 8 * fq;
        if (u.pn >= 4) {
            float rv[2][4];
#pragma unroll
            for (int ai = 0; ai < 2; ++ai)
#pragma unroll
                for (int m = 0; m < 4; ++m) rv[ai][m] = row_rinv(statc, u.pm * 256 + ai * 128 + wr * 64 + m * 16 + fr, 1.0f / KVLR);
#pragma unroll
            for (int ai = 0; ai < 2; ++ai)
#pragma unroll
                for (int m = 0; m < 4; ++m) {
                    const int row = u.pm * 256 + ai * 128 + wr * 64 + m * 16 + fr, b = row / SEQ, s = row % SEQ;
                    const float r = rv[ai][m];
#pragma unroll
                    for (int bj = 0; bj < 2; ++bj) { bf16_t* o = vimg + ((size_t)(b * NH + 2 * (u.pn - 4) + bj) * SEQ + s) * (VT_PITCH / 2) + cin; *(u32x4*)o = pack8(acc[ai][bj][m][0] * r, acc[ai][bj][m][1] * r); }
                }
            return;
        }
        float rr[2][4], pes[2][4];
        LAS float* Pw = P + (wr * 64 + fr) * 8 + wc;
#pragma unroll
        for (int ai = 0; ai < 2; ++ai)
#pragma unroll
            for (int m = 0; m < 4; ++m) {
                const int rl = ai * 128 + wr * 64 + m * 16 + fr; const float r = row_rinv(statc, u.pm * 256 + rl, 1.0f / KVLR); rr[ai][m] = r; pes[ai][m] = statpe[u.pm * 256 + rl];
                float ss[2];
#pragma unroll
                for (int bj = 0; bj < 2; ++bj) { const f32x4 a0 = acc[ai][bj][m][0] * r, a1 = acc[ai][bj][m][1] * r, q0 = a0 * a0, q1 = a1 * a1; ss[bj] = ((q0.x + q0.y) + (q0.z + q0.w)) + ((q1.x + q1.y) + (q1.z + q1.w)); }
#pragma unroll
                for (int bj = 0; bj < 2; ++bj) { ss[bj] += xshfl<16>(ss[bj]); ss[bj] = sum32(ss[bj]); }
                if (fq == 0) { Pw[(ai * 128 + m * 16) * 8] = ss[0]; Pw[(ai * 128 + m * 16) * 8 + 4] = ss[1]; }
            }
        asm volatile("s_waitcnt lgkmcnt(0)" ::: "memory"); __builtin_amdgcn_s_barrier(); asm volatile("" ::: "memory");
        __builtin_amdgcn_sched_barrier(0);
        const LAS float* Pr = P + (wr * 64 + fr) * 8;
        const f32x4 gk0 = *(const f32x4*)(g_k + cin), gk1 = *(const f32x4*)(g_k + cin + 4);
#pragma unroll
        for (int ai = 0; ai < 2; ++ai)
#pragma unroll
            for (int m = 0; m < 4; ++m) {
                const int rl = ai * 128 + wr * 64 + m * 16 + fr, row = u.pm * 256 + rl, b = row / SEQ, s = row % SEQ; const float pe = pes[ai][m];
#pragma unroll
                for (int bj = 0; bj < 2; ++bj) { const f32x4 p = *(const LAS f32x4*)(Pr + (ai * 128 + m * 16) * 8 + bj * 4);
                    const float sc = rsqrtf((((p.x + p.y) + (p.z + p.w)) + pe) * (1.0f / DQK) + EPS) * rr[ai][m];
                    bf16_t* o = kimg + ((size_t)(b * NH + 2 * u.pn + bj) * SEQ + s) * (KT_PITCH / 2) + cin; *(u32x4*)o = pack8(acc[ai][bj][m][0] * gk0 * sc, acc[ai][bj][m][1] * gk1 * sc); }
            }
        __builtin_amdgcn_sched_barrier(0);
        {
            const int tl = (wr * 4 + wc) * 64 + lane_now();
#pragma unroll 1
            for (int it = 0; it < 2; ++it) {
                const int item = tl + 512 * it, rl = item >> 2, c4 = item & 3, hfi = c4 & 1, second = c4 >> 1, row = u.pm * 256 + rl, b = row / SEQ, s = row % SEQ, pos = positions[row]; const float pe = statpe[row];
                const f32x4 pa = *(const LAS f32x4*)(P + (rl * 2 + 0) * 4), pb = *(const LAS f32x4*)(P + (rl * 2 + 1) * 4);
                const float rk0 = rsqrtf((((pa.x + pa.y) + (pa.z + pa.w)) + pe) * (1.0f / DQK) + EPS), rk1 = rsqrtf((((pb.x + pb.y) + (pb.z + pb.w)) + pe) * (1.0f / DQK) + EPS);
                const float* kp = kpe + (size_t)row * DR + 16 * hfi; const float* g1 = g_k + DN + 16 * hfi;
                bf16_t* ob0 = kimg + ((size_t)(b * NH + 2 * u.pn) * SEQ + s) * (KT_PITCH / 2) + DN + 16 * c4; bf16_t* ob1 = ob0 + (size_t)SEQ * (KT_PITCH / 2);
                f32x4 ov[4];
#pragma unroll
                for (int q4 = 0; q4 < 4; ++q4) { const f32x4 x1 = *(const f32x4*)(kp + 4 * q4) * *(const f32x4*)(g1 + 4 * q4), x2 = *(const f32x4*)(kp + 32 + 4 * q4) * *(const f32x4*)(g1 + 32 + 4 * q4);
#pragma unroll
                    for (int e = 0; e < 4; ++e) { float cs, sn; rope_cs(pos, 16 * hfi + 4 * q4 + e, cs, sn); ov[q4][e] = second ? x2[e] * cs + x1[e] * sn : x1[e] * cs - x2[e] * sn; } }
                *(u32x4*)ob0 = pack8(ov[0] * rk0, ov[1] * rk0); *(u32x4*)(ob0 + 8) = pack8(ov[2] * rk0, ov[3] * rk0);
                *(u32x4*)ob1 = pack8(ov[0] * rk1, ov[1] * rk1); *(u32x4*)(ob1 + 8) = pack8(ov[2] * rk1, ov[3] * rk1);
            }
        }
        asm volatile("s_waitcnt lgkmcnt(0)" ::: "memory");
    }
};

constexpr size_t MiB = 1u << 20;
constexpr size_t WS_CTL = 0, CTL_ZERO_BYTES = 64 * 1024;
constexpr size_t WS_SSQX = 1 * MiB, WS_SSQC = WS_SSQX + 256 * 1024, WS_SSQQ = WS_SSQC + 256 * 1024;
constexpr size_t WS_KPE = 2 * MiB;
constexpr size_t WS_WPOOL = 6 * MiB;
constexpr size_t WS_WKVQ = 7 * MiB;
constexpr size_t WS_WUKV = 9 * MiB;
constexpr size_t WS_WDQ1 = 11 * MiB;
constexpr size_t WS_WUQ = 11 * MiB + 512 * 1024;
constexpr size_t WS_WO = 13 * MiB;
constexpr size_t WS_WGU = 17 * MiB;
constexpr size_t WS_WD = 28 * MiB;
constexpr size_t WS_SSQPE = WS_SSQQ + 256 * 1024;
constexpr size_t WS_XB = 34 * MiB;
constexpr size_t WS_VT = 66 * MiB;
constexpr size_t WS_KF = 106 * MiB;
constexpr size_t WS_R = 156 * MiB;
constexpr size_t WS_WQI = 244 * MiB;
constexpr size_t WS_SSQX2 = 246 * MiB;
constexpr size_t WS_CQB = 247 * MiB;
constexpr size_t WS_END = 255 * MiB;
constexpr int CW_BAR = 4096;

constexpr int PT_OFF = MISC_OFF + 128;
static_assert(PT_OFF + 24 * 8 <= LDS_BYTES, "pointer table");
template <class T, int K> __device__ __forceinline__ T* ldptr(const LAS unsigned long long*) {
    unsigned a; asm volatile("v_mov_b32 %0, %1" : "=v"(a) : "n"(PT_OFF + 8 * K));
    const unsigned long long v = *(const LAS unsigned long long*)(size_t)a;
    const unsigned lo = __builtin_amdgcn_readfirstlane((unsigned)v), hi = __builtin_amdgcn_readfirstlane((unsigned)(v >> 32));
    GAS T* g = (GAS T*)(((unsigned long long)hi << 32) | lo);
    return (T*)g;
}
#define XB_TMO      128
#define XB_XCNT(j)  (256  + 64 * (j))
#define XB_XSUB(j)  (1280 + 64 * (j))
#define XB_XGEN(j)  (2304 + 64 * (j))
#define XB_TOP      3328
#define XB_TOPGEN   3392
#define XB_XT       3520
#define XB_DONE1    3840
#define XB_DONE2    3904
#define XB_GB       4096
#define XCD_BAR_WORDS 8192
#define XB_SPIN_CAP (1u << 18)
__device__ __forceinline__ unsigned xb_ld(unsigned* p)              { return __hip_atomic_load(p, __ATOMIC_RELAXED, __HIP_MEMORY_SCOPE_AGENT); }
__device__ __forceinline__ unsigned xb_add(unsigned* p, unsigned v) { return __hip_atomic_fetch_add(p, v, __ATOMIC_RELAXED, __HIP_MEMORY_SCOPE_AGENT); }
__device__ __forceinline__ unsigned xb_xcc_id() { return (unsigned)__builtin_amdgcn_s_getreg((3 << 11) | 20) & 0xFu; }
#define XB_SPIN(cond, bar) do { unsigned _sp = 0; while (cond) { __builtin_amdgcn_s_sleep(1); \
    if ((++_sp & 255u) == 0u) { if (xb_ld(&(bar)[XB_TMO])) break; if (_sp > XB_SPIN_CAP) { atomicAdd(&(bar)[XB_TMO], 1u); break; } } } } while (0)
struct XcdBarrier { const LAS unsigned long long* PT; volatile LAS unsigned* st; int wave; };
__device__ __forceinline__ unsigned* xb_words(const LAS unsigned long long* PT) { return (unsigned*)(ldptr<unsigned char, 23>(PT) + WS_CTL) + CW_BAR; }
__device__ __forceinline__ bool xb_leader(int wave) { unsigned lane; asm volatile("v_mbcnt_lo_u32_b32 %0, -1, 0\n\tv_mbcnt_hi_u32_b32 %0, -1, %0" : "=v"(lane)); return wave == 0 && lane == 0; }
__device__ __forceinline__ void xcd_barrier_post(const XcdBarrier& b) {
    if (xb_leader(b.wave)) { unsigned* bar = xb_words(b.PT); const unsigned x = xb_xcc_id();
        if (gridDim.x == 256) (void)xb_add(&bar[XB_XT + blockIdx.x], x + 1u);
        (void)xb_add(&bar[XB_XCNT(x)], 1u); }
}
__device__ __forceinline__ void xcd_barrier_complete(unsigned* bar, unsigned x, unsigned& nloc, unsigned& nx) {
    const unsigned G = gridDim.x * gridDim.y * gridDim.z;
    unsigned sum, cnt, mine, sp = 0u;
    for (;;) {
        sum = 0u; cnt = 0u; mine = 0u;
#pragma unroll
        for (unsigned j = 0; j < 16; ++j) { const unsigned c = xb_ld(&bar[XB_XCNT(j)]); sum += c; cnt += (c > 0u) ? 1u : 0u; mine = (j == x) ? c : mine; }
        if (sum == G) break;
        __builtin_amdgcn_s_sleep(1);
        if ((++sp & 255u) == 0u) { if (xb_ld(&bar[XB_TMO])) break; if (sp > XB_SPIN_CAP) { atomicAdd(&bar[XB_TMO], 1u); break; } }
    }
    nloc = mine > 0u ? mine : 1u; nx = cnt > 0u ? cnt : 1u;
}
__device__ __forceinline__ unsigned xcd_group_colocated(unsigned* bar, unsigned x) {
    if (gridDim.x != 256) return 0u;
    unsigned ok = 1u;
    for (unsigned k = 0; k < 4; ++k) {
        unsigned v = 0u, sp = 0u;
        while ((v = xb_ld(&bar[XB_XT + (blockIdx.x & 63u) + 64u * k])) == 0u) { __builtin_amdgcn_s_sleep(1); if (++sp > XB_SPIN_CAP) { ok = 0u; break; } }
        if (v != x + 1u) ok = 0u;
    }
    return ok;
}
__device__ __forceinline__ void xcd_barrier(const XcdBarrier& b, bool light = false) {
    asm volatile("s_waitcnt vmcnt(0)" ::: "memory");
    __syncthreads();
    if (xb_leader(b.wave)) {
        unsigned* bar = xb_words(b.PT); const unsigned x = xb_xcc_id();
        __builtin_amdgcn_s_waitcnt(0);
        unsigned nloc = b.st[0], nx = b.st[1];
        if (nloc == 0u) { xcd_barrier_complete(bar, x, nloc, nx); b.st[0] = nloc; b.st[1] = nx; b.st[2] = xcd_group_colocated(bar, x); }
        const bool skip_wb = light && b.st[2] != 0u;
        if (light && !skip_wb) { __builtin_amdgcn_fence(__ATOMIC_RELEASE, "agent"); asm volatile("s_waitcnt vmcnt(0)" ::: "memory"); }
        const unsigned old = xb_add(&bar[XB_XSUB(x)], 1u);
        const unsigned gen = old / nloc;
        if (old + 1u == (gen + 1u) * nloc) {
            if (!light) { __builtin_amdgcn_fence(__ATOMIC_RELEASE, "agent"); }
            asm volatile("s_waitcnt vmcnt(0)" ::: "memory");
            const unsigned og = xb_add(&bar[XB_TOP], 1u);
            const unsigned tg = og / nx;
            if (og + 1u == (tg + 1u) * nx) xb_add(&bar[XB_TOPGEN], 1u);
            else XB_SPIN(xb_ld(&bar[XB_TOPGEN]) == tg, bar);
            __builtin_amdgcn_fence(__ATOMIC_ACQUIRE, "agent");
            xb_add(&bar[XB_XGEN(x)], 1u);
            asm volatile("s_waitcnt vmcnt(0)" ::: "memory");
        } else {
            XB_SPIN(xb_ld(&bar[XB_XGEN(x)]) == gen, bar);
            __builtin_amdgcn_fence(__ATOMIC_ACQUIRE, "agent");
            asm volatile("s_waitcnt vmcnt(0)" ::: "memory");
        }
    }
    __syncthreads();
}

__device__ __forceinline__ bool grid_is_256() { unsigned g = gridDim.x; asm volatile("" : "+s"(g)); return g == 256u; }
__device__ __forceinline__ void group_barrier(const XcdBarrier& b, int done_word = -1) {
    if (!grid_is_256()) { xcd_barrier(b, true); return; }
    asm volatile("s_waitcnt vmcnt(0)" ::: "memory");
    __syncthreads();
    if (xb_leader(b.wave)) {
        unsigned* bar = xb_words(b.PT);
        __builtin_amdgcn_s_waitcnt(0);
        if (done_word >= 0) (void)xb_add(&bar[done_word], 1u);
        if (b.st[2] == 0u) { __builtin_amdgcn_fence(__ATOMIC_RELEASE, "agent"); asm volatile("s_waitcnt vmcnt(0)" ::: "memory"); }
        const unsigned use = b.st[3]; b.st[3] = use + 1u;
        unsigned* gc = &bar[XB_GB + 64u * (blockIdx.x & 63u)];
        (void)xb_add(gc, 1u);
        XB_SPIN(xb_ld(gc) < 4u * (use + 1u), bar);
        __builtin_amdgcn_fence(__ATOMIC_ACQUIRE, "agent");
        asm volatile("s_waitcnt vmcnt(0)" ::: "memory");
    }
    __syncthreads();
}

__device__ __forceinline__ void all_done_wait(const XcdBarrier& b, int done_word) {
    if (!grid_is_256() || !GROUP_SEAMS) return;
    if (xb_leader(b.wave)) { unsigned* bar = xb_words(b.PT); XB_SPIN(xb_ld(&bar[done_word]) < 256u, bar); }
    __syncthreads();
}

struct EpiDump {
    static constexpr bool PERM = true, AFTER_DRAIN = false;
    u32x4* part;
    __device__ __forceinline__ void operator()(const f32x4 (&acc)[2][2][4][2], const pg8::Unit&, int wr, int wc, int, int) const {
        u32x4* o = part + (wr * 4 + wc) * 64 + lane_now();
#pragma unroll
        for (int ai = 0; ai < 2; ++ai)
#pragma unroll
            for (int bj = 0; bj < 2; ++bj)
#pragma unroll
                for (int m = 0; m < 4; ++m) o[((ai * 2 + bj) * 4 + m) * 512] = pack8(acc[ai][bj][m][0], acc[ai][bj][m][1]);
    }
};
template <class E> struct EpiAddThen {
    static constexpr bool PERM = true, AFTER_DRAIN = false;
    E e; const u32x4* part; unsigned* flag; unsigned target;
    __device__ __forceinline__ void operator()(const f32x4 (&acc_)[2][2][4][2], const pg8::Unit& u, int wr, int wc, int fr, int fq) const {
        f32x4 (&acc)[2][2][4][2] = const_cast<f32x4 (&)[2][2][4][2]>(acc_);
        { unsigned sp = 0; while (xb_ld(flag) < target) { __builtin_amdgcn_s_sleep(1); if (++sp > XB_SPIN_CAP) break; } }
        __builtin_amdgcn_fence(__ATOMIC_ACQUIRE, "agent");
        const u32x4* o = part + (wr * 4 + wc) * 64 + lane_now();
#pragma unroll
        for (int ai = 0; ai < 2; ++ai) {
            u32x4 h[2][4];
#pragma unroll
            for (int bj = 0; bj < 2; ++bj)
#pragma unroll
                for (int m = 0; m < 4; ++m) h[bj][m] = o[((ai * 2 + bj) * 4 + m) * 512];
#pragma unroll
            for (int bj = 0; bj < 2; ++bj)
#pragma unroll
                for (int m = 0; m < 4; ++m) { const u32x4 v = h[bj][m];
                    acc[ai][bj][m][0] += (f32x4){bflo(v.x), bfhi(v.x), bflo(v.y), bfhi(v.y)}; acc[ai][bj][m][1] += (f32x4){bflo(v.z), bfhi(v.z), bflo(v.w), bfhi(v.w)}; }
        }
        e(acc_, u, wr, wc, fr, fq);
    }
};

#ifndef ATTN_MODE
#define ATTN_MODE 1
#endif
#ifndef ONE_LAUNCH
#define ONE_LAUNCH 1
#endif
constexpr int NPH = 18;
struct Args { const void* in[22]; float* out; unsigned char* ws; int lo, hi; };

constexpr int RTAB_OFF = STATP_OFF + 8192;
static_assert(RTAB_OFF + 1024 <= MISC_OFF, "LDS map");
__device__ __forceinline__ int prep_rtab(const Frame& F, const pg8::Gemm g, const float* stat, float invn) {
    pg8::StaticOrder S; S.init(g.M, g.N, F.G, (int)blockIdx.x); pg8::Unit u; int pm = -1;
    if (S.next(0, u)) { pm = u.pm; if (F.tid < 256) ((LAS float*)(F.lds + RTAB_OFF))[F.tid] = row_rinv(stat, u.pm * 256 + F.tid, invn); }
    asm volatile("s_waitcnt lgkmcnt(0)" ::: "memory"); __syncthreads();
    return pm;
}
#define RTAB_PTR ((const LAS float*)(F.lds + RTAB_OFF))
struct RtabHook {
    f32x4 p; float invn; LAS float* rt; int tid; bool on;
    __device__ __forceinline__ void operator()() const {
        if (on && tid < 256) rt[tid] = rsqrtf(((p.x + p.y) + (p.z + p.w)) * invn + EPS);
        asm volatile("s_waitcnt lgkmcnt(0)" ::: "memory");
    }
};
__device__ __forceinline__ RtabHook rtab_issue(const Frame& F, const pg8::Gemm g, const float* stat, float invn, int& pm) {
    pg8::StaticOrder S; S.init(g.M, g.N, F.G, (int)blockIdx.x); pg8::Unit u; pm = -1;
    RtabHook h{(f32x4){1.f, 0.f, 0.f, 0.f}, invn, (LAS float*)(F.lds + RTAB_OFF), F.tid, false};
    if (S.next(0, u)) { pm = u.pm; h.on = true; if (F.tid < 256) h.p = *(const f32x4*)(stat + 4 * (size_t)(u.pm * 256 + F.tid)); }
    return h;
}
template <class Q, class Hook = pg8::NoHook> __device__ __forceinline__ void run_gemm(const Frame& F, const pg8::Gemm g, const Q& q, const Hook& hook = Hook()) {
    pg8::StaticOrder S; S.init(g.M, g.N, F.G, (int)blockIdx.x);
    const pg8::EpiQuad<Q> E{q};
    pg8::gemm_phase<pg8::EpiQuad<Q>, pg8::StaticOrder, true, true, Hook>(F.lds, g, S, E, F.tid, hook);
}
template <class Q, class Hook = pg8::NoHook> __device__ __forceinline__ void run_gemm_stat(const Frame& F, const pg8::Gemm g, const Q& q, const Hook& hook = Hook()) {
    pg8::StaticOrder S; S.init(g.M, g.N, F.G, (int)blockIdx.x);
    const pg8::EpiQuadStat<Q> E{q, (LAS float*)(F.lds + STATP_OFF), F.tid};
    pg8::gemm_phase<pg8::EpiQuadStat<Q>, pg8::StaticOrder, true, true, Hook>(F.lds, g, S, E, F.tid, hook);
}

__global__ void __launch_bounds__(NWAVES * 64, 2) mk_fwd(Args args) {
    extern __shared__ __attribute__((aligned(16))) unsigned char lds_raw[];
    Frame F0;
    F0.lds = (LAS unsigned char*)lds_raw; F0.MISC = (volatile LAS unsigned*)(F0.lds + MISC_OFF);
    F0.tid = threadIdx.x; F0.lane = F0.tid & 63; F0.wave = __builtin_amdgcn_readfirstlane(F0.tid >> 6);
    F0.G = gridDim.x; { const int bx = blockIdx.x; F0.vcu = (F0.G % 8 == 0) ? (bx % 8) * (F0.G / 8) + bx / 8 : bx; }
    F0.gw = F0.vcu * NWAVES + F0.wave; F0.ngw = F0.G * NWAVES;
    for (int u = F0.tid; u < (LDS_BYTES - RING_BYTES) / 4; u += NWAVES * 64) ((LAS unsigned*)(F0.lds + RING_BYTES))[u] = 0u;
    __syncthreads();
    LAS unsigned long long* PTw = (LAS unsigned long long*)(F0.lds + PT_OFF);
    if (F0.tid == 0) {
#define PT_SET(k) PTw[k] = (unsigned long long)args.in[k]
        PT_SET(0); PT_SET(1); PT_SET(2); PT_SET(3); PT_SET(4); PT_SET(5); PT_SET(6); PT_SET(7); PT_SET(8); PT_SET(9); PT_SET(10); PT_SET(11);
        PT_SET(12); PT_SET(13); PT_SET(14); PT_SET(15); PT_SET(16); PT_SET(17); PT_SET(18); PT_SET(19); PT_SET(20); PT_SET(21);
#undef PT_SET
        PTw[22] = (unsigned long long)args.out; PTw[23] = (unsigned long long)args.ws;
    }
    __syncthreads();
    const LAS unsigned long long* PT = (const LAS unsigned long long*)(F0.lds + PT_OFF);
    const XcdBarrier bar{PT, F0.MISC + 8, F0.wave};
#if ONE_LAUNCH
    xcd_barrier_post(bar);
#endif
#define IN_F(k) ldptr<const float, k>(PT)
#define X_IN IN_F(0)
#define POSITIONS ldptr<const int, 1>(PT)
#define LN_MIX_A IN_F(2)
#define W_POOL IN_F(3)
#define B_POOL IN_F(4)
#define POOL_SCALE IN_F(5)
#define LN_FFN IN_F(6)
#define W_GATE IN_F(7)
#define W_UP IN_F(8)
#define W_DOWN IN_F(9)
#define LN_KV IN_F(10)
#define W_DKV IN_F(11)
#define G_KV_LATENT IN_F(12)
#define W_UK IN_F(13)
#define W_UV IN_F(14)
#define G_K IN_F(15)
#define LN_MIX_B IN_F(16)
#define W_DQ IN_F(17)
#define G_Q_LATENT IN_F(18)
#define W_UQ IN_F(19)
#define G_Q IN_F(20)
#define W_O IN_F(21)
#define XO ldptr<float, 22>(PT)
#define WSB(T, off) ((T*)(ldptr<unsigned char, 23>(PT) + (off)))
#define SSQX WSB(float, WS_SSQX)
#define SSQC WSB(float, WS_SSQC)
#define SSQQ WSB(float, WS_SSQQ)
#define SSQPE WSB(float, WS_SSQPE)
#define KPE WSB(float, WS_KPE)
#define WPOOL_T WSB(bf16_t, WS_WPOOL)
#define WKVQ_T WSB(bf16_t, WS_WKVQ)
#define WUKV_T WSB(bf16_t, WS_WUKV)
#define WDQ1_T WSB(bf16_t, WS_WDQ1)
#define WUQ_T WSB(bf16_t, WS_WUQ)
#define WO_T WSB(bf16_t, WS_WO)
#define WGU_T WSB(bf16_t, WS_WGU)
#define WD_T WSB(bf16_t, WS_WD)
#define XB WSB(bf16_t, WS_XB)
#define VT WSB(bf16_t, WS_VT)
#define KFIN WSB(bf16_t, WS_KF)
#define WQI WSB(bf16_t, WS_WQI)
#define SSQX2 WSB(float, WS_SSQX2)
#define SSQIN WSB(float, WS_SSQX2 + 256 * 1024)
#define SSQ3 WSB(float, WS_SSQX2 + 512 * 1024)
#define XB2 WSB(bf16_t, WS_KF + 17 * MiB)
#define HID WSB(bf16_t, WS_R)
#define DPOOL WSB(bf16_t, WS_VT)
#define QB_ WSB(bf16_t, WS_R)
#define CKVB (WSB(bf16_t, WS_R) + CKV_OFF)
#define OB_ WSB(bf16_t, WS_R + 48 * MiB)
#define CQB WSB(bf16_t, WS_CQB)

    const int lo = args.lo, hi = args.hi; int ph = 0;
#if ONE_LAUNCH
#define PH_COND true
#define PH_BAR_COND true
#else
#define PH_COND (ph >= lo && ph < hi)
#define PH_BAR_COND (ph + 1 < hi)
#endif
#define PH_BEGIN if (PH_COND) { Frame F = F0; asm volatile("v_mbcnt_lo_u32_b32 %0, -1, 0\n\tv_mbcnt_hi_u32_b32 %0, -1, %0" : "=v"(F.lane) :: "memory"); asm volatile("" : "+s"(F.G), "+s"(F.gw), "+s"(F.ngw), "+s"(F.vcu), "+s"(F.wave)); F.tid = F.wave * 64 + F.lane;
#define PH_END   if (PH_BAR_COND) xcd_barrier(bar); } ++ph;
#define PH_END_L if (PH_BAR_COND) xcd_barrier(bar, LIGHT_SEAMS); } ++ph;
#define WGU_L(l) WSB(bf16_t, (l) == 1 ? WS_KF : WS_WGU)
#define WD_L(l) WSB(bf16_t, (l) == 1 ? WS_KF + 11 * MiB : WS_WD)
#define PREP_FFN(l) do { int rot_ = 0; PREP_FFN_R(l); } while (0)
#define PREP_FFN_R(l) do { const float* lnf_ = LN_FFN + (l) * DM; bf16_t* wgu_ = WGU_L(l); \
                         prep_mat(F, rot_, W_GATE + (size_t)(l) * DM * DFF, DFF, DM, DFF, 0, lnf_, wgu_, RM_GATE, 0); \
                         prep_mat(F, rot_, W_UP + (size_t)(l) * DM * DFF, DFF, DM, DFF, 0, lnf_, wgu_, RM_UP, 0); \
                         prep_mat(F, rot_, W_DOWN + (size_t)(l) * DFF * DM, DM, DFF, DM, 0, nullptr, WD_L(l), RM_PLAIN, 0); } while (0)
#define SPLIT6 1
#define early_prep grid_is_256()

    PH_BEGIN
        int rot_ = 0;
        for (int l = 0; l < 2; ++l) for (int g = 0; g < 4; ++g)
            prep_mat(F, rot_, W_POOL + (size_t)(l * 4 + g) * 65536, 256, 256, 256, 0, nullptr, WPOOL_T + (size_t)l * 1024 * 256, RM_PLAIN, 256 * g);
        prep_mat(F, rot_, W_DKV, 576, DM, 512, 0, LN_KV, WKVQ_T, RM_PLAIN, 0);
        prep_mat(F, rot_, W_DQ, QLR, DM, QLR, 0, LN_MIX_B, WKVQ_T, RM_PLAIN, 512);
        prep_mat(F, rot_, W_DKV, 576, DM, DR, 512, LN_KV, WKVQ_T, RM_PLAIN, 768);
        { bf16_t* wk = WKVQ_T; for (int i = F.vcu * 512 + F.tid; i < 192 * 1024 / 8; i += F.G * 512) *(u32x4*)(wk + (size_t)832 * 1024 + 8 * (size_t)i) = (u32x4){0u, 0u, 0u, 0u}; }
        prep_mat(F, rot_, W_UK, DM, KVLR, DM, 0, G_KV_LATENT, WUKV_T, RM_PLAIN, 0);
        prep_mat(F, rot_, W_UV, DM, KVLR, DM, 0, G_KV_LATENT, WUKV_T, RM_PLAIN, 1024);
        prep_mat(F, rot_, W_DQ + (size_t)DM * QLR, QLR, DM, QLR, 0, LN_MIX_B + DM, WDQ1_T, RM_PLAIN, 0);
        for (int j = 0; j < 2; ++j) prep_mat(F, rot_, W_UQ + (size_t)j * QLR * 1536, 1536, QLR, 1536, 0, G_Q_LATENT + j * QLR, WUQ_T + (size_t)j * 1536 * QLR, RM_PLAIN, 0);
        for (int j = 0; j < 2; ++j) prep_mat(F, rot_, W_O + (size_t)j * DM * DM, DM, DM, DM, 0, nullptr, WO_T + (size_t)j * DM * DM, RM_PLAIN, 0);
        PREP_FFN_R(0);
        rowstat_x(F, X_IN, SSQIN);
    PH_END

    for (int l = 0; l < 4; ++l) {
        if (l < 2) {
            PH_BEGIN { if (l > 0 && !early_prep) PREP_FFN(l);
                       if (l == 0) prep_wqimg(F, WUQ_T, WQI);
                       const pg8::Gemm g{DPOOL, WPOOL_T + (size_t)l * 1024 * 256, M, DM, 256, DM, 256, 256};
                       { pg8::StaticOrder S; S.init(g.M, g.N, F.G, (int)blockIdx.x); pg8::Unit u; const float* st = l == 0 ? SSQIN : SSQ3; const float* ga = LN_MIX_A + l * DM; bf16_t* dp = DPOOL;
                         if (l == 0) { const float* xs = X_IN; for (int i = 0; S.next(i, u); ++i) pool_prep_unit(F, xs, st, ga, dp, u.pm, u.pn); }
                         else { const bf16_t* xs = XB2; for (int i = 0; S.next(i, u); ++i) pool_prep_unit(F, xs, st, ga, dp, u.pm, u.pn); } }
                       asm volatile("s_waitcnt vmcnt(0)" ::: "memory"); __syncthreads();
                       const QResidual q{l == 0 ? X_IN : (const float*)nullptr, nullptr, XB, B_POOL + l * DM, POOL_SCALE + l * DM, SSQX2  , l == 0 ? (const bf16_t*)nullptr : (const bf16_t*)XB2}; run_gemm_stat(F, g, q); } if (PH_BAR_COND) { if (GROUP_SEAMS) group_barrier(bar); else xcd_barrier(bar, LIGHT_SEAMS); } } ++ph;
        } else {
            const int j = l - 2;
            if (j == 1) {
                PH_BEGIN { const int nun = (M / 256) * (QLR / 256);
                           if (SPLIT6) all_done_wait(bar, XB_DONE2);
                           if ((int)blockIdx.x >= nun || F.G <= nun) { Frame Fp = F; if (F.G > nun) { Fp.gw = ((int)blockIdx.x - nun) * NWAVES + F.wave; Fp.ngw = (F.G - nun) * NWAVES; }
                               all_done_wait(bar, XB_DONE2);
                               { const Frame& F = Fp; PREP_FFN(l); } __syncthreads(); }
                           const pg8::Gemm g{XB, WDQ1_T, M, QLR, DM, DM, DM, 0}; const float* st_ = SSQX; int tpm_; const RtabHook hk_ = rtab_issue(F, g, st_, 1.0f / DM, tpm_); const QRowScale q{CQB, QLR, st_, 1.0f / DM, SSQQ, RTAB_PTR, tpm_}; run_gemm_stat(F, g, q, hk_); } PH_END
            }
            PH_BEGIN attn_phase(F, QB_, CQB, SSQQ, WQI + (size_t)j * NH * (WQI_HEAD / 2), KFIN, VT, WSB(bf16_t, WS_R), OB_, G_Q + j * DQK, G_K, POSITIONS, [&]() { xcd_barrier(bar); },
                                [&]() { const pg8::Gemm g{CQB, WUQ_T + (size_t)j * 1536 * QLR, M, 1536, QLR, QLR, QLR, 0}; const float* st_ = SSQQ; const int tpm_ = prep_rtab(F, g, st_, 1.0f / QLR);
                                        const QRowScale q{QB_, 1536, st_, 1.0f / QLR, nullptr, RTAB_PTR, tpm_}; run_gemm(F, g, q); }); PH_END
            PH_BEGIN { const bool slots_ = F.MISC[24] != 0u;
                       const pg8::Gemm g{slots_ ? WSB(bf16_t, WS_R) : OB_, WO_T + (size_t)j * DM * DM, M, DM, DM, DM, DM, 0, slots_ ? OSLOT_ELEMS * 2 : (size_t)0}; const QResidual q{nullptr, nullptr, XB, nullptr, nullptr, SSQX}; run_gemm_stat(F, g, q);
                       if (PH_BAR_COND) { if (GROUP_SEAMS && slots_) group_barrier(bar); else xcd_barrier(bar, LIGHT_SEAMS); } } } ++ph;
        }
        PH_BEGIN { const pg8::Gemm g{XB, WGU_L(l), M, NGU, DM, DM, DM, 0}; const float* st_ = l < 2 ? SSQX2 : SSQX; int tpm_; const RtabHook hk_ = rtab_issue(F, g, st_, 1.0f / DM, tpm_); const QGateUp q{HID, st_, RTAB_PTR, tpm_};
                   if (SPLIT6 && l >= 2 && grid_is_256()) {
                       const pg8::EpiQuad<QGateUp> E{q};
                       { pg8::LimitOrder S5; S5.S.init(g.M, g.N, F.G, (int)blockIdx.x); S5.lim = 5; pg8::gemm_phase<pg8::EpiQuad<QGateUp>, pg8::LimitOrder, true, true, RtabHook>(F.lds, g, S5, E, F.tid, hk_); }
                       int c_ = (int)blockIdx.x; asm volatile("" : "+s"(c_) :: "memory");
                       const int own_ = c_ & 127, kh_ = c_ >> 7;
                       pg8::OneUnit S1; { pg8::StaticOrder So; So.init(g.M, g.N, 256, own_); S1.ok = So.next(5, S1.u); asm volatile("" : "+s"(S1.u.pm), "+s"(S1.u.pn)); }
                       const pg8::Gemm gh{XB + 512 * kh_, WGU_L(l) + 512 * kh_, M, NGU, DM / 2, DM, DM, 0};
                       u32x4* part_ = (u32x4*)(own_ < 72 ? WSB(unsigned char, 2 * MiB + (size_t)own_ * 131072) : WSB(unsigned char, WS_CQB + (size_t)(own_ - 72) * 131072));
                       unsigned* flag_ = xb_words(PT) + XB_GB + 64 * (c_ & 63) + 16 + 16 * ((c_ >> 6) & 1);
                       if (kh_ == 1) { const EpiDump Ed{part_}; pg8::gemm_phase<EpiDump, pg8::OneUnit, true, true>(F.lds, gh, S1, Ed, F.tid);
                           asm volatile("s_waitcnt vmcnt(0)" ::: "memory"); __syncthreads();
                           if (xb_leader(F.wave)) { if (bar.st[2] == 0u) { __builtin_amdgcn_fence(__ATOMIC_RELEASE, "agent"); asm volatile("s_waitcnt vmcnt(0)" ::: "memory"); } (void)xb_add(flag_, 1u); } }
                       else { const EpiAddThen<pg8::EpiQuad<QGateUp>> Ea{E, part_, flag_, (unsigned)(l - 1)}; pg8::gemm_phase<EpiAddThen<pg8::EpiQuad<QGateUp>>, pg8::OneUnit, true, true>(F.lds, gh, S1, Ea, F.tid); }
                   } else run_gemm(F, g, q, hk_);
                   if (early_prep && l < 2 && (int)blockIdx.x >= 128) {
                       Frame Fp = F; Fp.gw = ((int)blockIdx.x - 128) * NWAVES + F.wave; Fp.ngw = 128 * NWAVES;
                       { const Frame& F = Fp; PREP_FFN(l + 1); } } } if (PH_BAR_COND) { if (GROUP_SEAMS) group_barrier(bar); else xcd_barrier(bar, LIGHT_SEAMS); } } ++ph;
        PH_BEGIN { const pg8::Gemm g{HID, WD_L(l), M, DM, DFF, DFF, DFF, 0}; const QResidual q{nullptr, l == 3 ? XO : (float*)nullptr, l == 0 ? XB2 : XB, nullptr, nullptr, l == 0 ? SSQ3 : SSQX, l == 0 ? (const bf16_t*)XB : (const bf16_t*)nullptr}; run_gemm_stat(F, g, q); } if (PH_BAR_COND && l < 3) { if (GROUP_SEAMS && l >= 1) group_barrier(bar, l == 1 ? XB_DONE1 : XB_DONE2); else xcd_barrier(bar, LIGHT_SEAMS && (l == 1 || l == 2)); } } ++ph;
        if (l == 1) {
            PH_BEGIN { if (!early_prep) { PREP_FFN(2); __syncthreads(); } const pg8::Gemm g{XB, WKVQ_T, M, DM, DM, DM, DM, 0}; const float* st_ = SSQX; int tpm_; const RtabHook hk_ = rtab_issue(F, g, st_, 1.0f / DM, tpm_); const QKvd q{CKVB, CQB, KPE, st_, SSQC, SSQQ, SSQPE, RTAB_PTR, tpm_}; run_gemm_stat(F, g, q, hk_); } if (PH_BAR_COND) { if (GROUP_SEAMS) group_barrier(bar); else xcd_barrier(bar, LIGHT_SEAMS); } } ++ph;
            PH_BEGIN { all_done_wait(bar, XB_DONE1);
                       const pg8::Gemm g{CKVB, WUKV_T, M, 2048, KVLR, KVLR, KVLR, 0, CKV_TSTEP * 2}; pg8::StaticOrder S; S.init(g.M, g.N, F.G, (int)blockIdx.x);
                       const EpiKvu E{KFIN, VT, SSQC, SSQPE, KPE, G_K, POSITIONS, (LAS float*)(F.lds + STATP_OFF), F.tid};
                       pg8::gemm_phase<EpiKvu, pg8::StaticOrder, true, true>(F.lds, g, S, E, F.tid); } PH_END
        }
    }
#undef PH_BEGIN
#undef PH_END
#undef PH_END_L
#undef PREP_FFN
#undef PREP_FFN_R
#undef early_prep
}

extern "C" void kernel_launch(void* const* d_in, const int* in_sizes, int n_in, void* d_out, int out_size, void* d_ws, size_t ws_size, hipStream_t stream) {
    static int grid = 0;
    if (grid == 0) {
        if (n_in != 22 || in_sizes[0] != M * DM || out_size != M * DM || ws_size < WS_END) { fprintf(stderr, "kernel_launch: unexpected shapes (n_in %d, in0 %d, out %d, ws %zu)\n", n_in, n_in > 0 ? in_sizes[0] : -1, out_size, ws_size); grid = -1; return; }
        int dev = 0, cus = 0, per_cu = 0;
        if (hipGetDevice(&dev) != hipSuccess || hipDeviceGetAttribute(&cus, hipDeviceAttributeMultiprocessorCount, dev) != hipSuccess) { grid = -1; return; }
        if (hipFuncSetAttribute((const void*)mk_fwd, hipFuncAttributeMaxDynamicSharedMemorySize, LDS_BYTES) != hipSuccess) { fprintf(stderr, "kernel_launch: hipFuncSetAttribute failed\n"); grid = -1; return; }
        if (hipOccupancyMaxActiveBlocksPerMultiprocessor(&per_cu, (const void*)mk_fwd, NWAVES * 64, LDS_BYTES) != hipSuccess || per_cu < 1) { fprintf(stderr, "kernel_launch: occupancy query reports %d blocks per CU\n", per_cu); grid = -1; (void)hipGetLastError(); return; }
        grid = cus;
    }
    if (grid < 0) return;
    if (hipMemsetAsync((char*)d_ws + WS_CTL, 0, CTL_ZERO_BYTES, stream) != hipSuccess) return;
    Args a{};
    for (int i = 0; i < 22; ++i) a.in[i] = d_in[i];
    a.out = (float*)d_out; a.ws = (unsigned char*)d_ws;
#if ONE_LAUNCH
    a.lo = 0; a.hi = 1000;
    hipLaunchKernelGGL(mk_fwd, dim3(grid), dim3(NWAVES * 64), LDS_BYTES, stream, a);
#else
    for (int p = 0; p < NPH; ++p) { a.lo = p; a.hi = p + 1; hipLaunchKernelGGL(mk_fwd, dim3(grid), dim3(NWAVES * 64), LDS_BYTES, stream, a); }
#endif
}
```

```cpp
#define GROUP_SEAMS true
#define LIGHT_SEAMS true
#include <hip/hip_runtime.h>
#include <cstdio>
#include <cstdint>

#define LAS __attribute__((address_space(3)))
#define GAS __attribute__((address_space(1)))
typedef unsigned short bf16_t;
typedef short bf16x8 __attribute__((ext_vector_type(8)));
typedef float f32x4 __attribute__((ext_vector_type(4)));
typedef float f32x16 __attribute__((ext_vector_type(16)));
typedef unsigned u32x4 __attribute__((ext_vector_type(4)));
typedef unsigned u32x2 __attribute__((ext_vector_type(2)));

constexpr int BATCH = 4, SEQ = 4096, DM = 1024, M = BATCH * SEQ, DFF = 2816, NH = 8, DN = 128, DR = 64, DQK = 192, DV = 128, QLR = 256, KVLR = 512;
constexpr int NGU = 2 * DFF;
constexpr float EPS = 1e-6f;
constexpr float QSCALE = 0.07216878364870322f * 1.4426950408889634f;

__device__ __forceinline__ unsigned cvt_pk_bf16(float lo, float hi) { unsigned r; asm volatile("v_cvt_pk_bf16_f32 %0, %1, %2" : "=v"(r) : "v"(lo), "v"(hi)); return r; }
__device__ __forceinline__ u32x4 pack8(f32x4 a, f32x4 b) { u32x4 w; w.x = cvt_pk_bf16(a[0], a[1]); w.y = cvt_pk_bf16(a[2], a[3]); w.z = cvt_pk_bf16(b[0], b[1]); w.w = cvt_pk_bf16(b[2], b[3]); return w; }
__device__ __forceinline__ float bf2f(unsigned v) { return __uint_as_float(v << 16); }
__device__ __forceinline__ float bflo(unsigned w) { return __uint_as_float(w << 16); }
__device__ __forceinline__ float bfhi(unsigned w) { return __uint_as_float(w & 0xffff0000u); }
__device__ __forceinline__ int lane_now() { unsigned l; asm volatile("v_mbcnt_lo_u32_b32 %0, -1, 0\n\tv_mbcnt_hi_u32_b32 %0, -1, %0" : "=v"(l)); return (int)l; }
template <int N> __device__ __forceinline__ float xshfl(float v) {
    static_assert(N < 32, "xshfl: use sum32 / max32 across the halves");
    return __int_as_float(__builtin_amdgcn_ds_swizzle(__float_as_int(v), 0x1F | (N << 10)));
}
__device__ __forceinline__ float wave_sum(float v) {
    v += xshfl<1>(v); v += xshfl<2>(v); v += xshfl<4>(v); v += xshfl<8>(v); v += xshfl<16>(v);
    { const auto rr = __builtin_amdgcn_permlane32_swap(__float_as_uint(v), __float_as_uint(v), false, false); v = __uint_as_float(rr[0]) + __uint_as_float(rr[1]); }
    return v;
}
__device__ __forceinline__ float sum32(float v) { const auto rr = __builtin_amdgcn_permlane32_swap(__float_as_uint(v), __float_as_uint(v), false, false); return __uint_as_float(rr[0]) + __uint_as_float(rr[1]); }
__device__ __forceinline__ float max32(float v) { const auto rr = __builtin_amdgcn_permlane32_swap(__float_as_uint(v), __float_as_uint(v), false, false); return fmaxf(__uint_as_float(rr[0]), __uint_as_float(rr[1])); }
__device__ __forceinline__ float row_rinv(const float* stat, int row, float invn) { const f32x4 p = *(const f32x4*)(stat + 4 * (size_t)row); return rsqrtf(((p.x + p.y) + (p.z + p.w)) * invn + EPS); }

namespace pg8 {
constexpr int BM = 256, BK = 64, HALF = 128, HTB = HALF * BK * 2  , STAGE_BYTES = 8 * HTB, NXCD = 8, WGM = 8;
__host__ __device__ __forceinline__ int lds_byte(int r, int c) { const int st = (r >> 4) * 2 + (c >> 5), rr = r & 15, cc = c & 31, ob = rr * 64 + cc * 2; return st * 1024 + (ob ^ (((ob >> 9) & 1) << 5)); }
__host__ __device__ __forceinline__ void stage_rc(int b, int& R, int& C) { const int st = b / 1024, sb = b % 1024, swz = sb ^ (((sb >> 9) & 1) << 5); R = (st >> 1) * 16 + swz / 64; C = (st & 1) * 32 + (swz % 64) / 2; }
__host__ __device__ __forceinline__ int perm32(int rho) { const int n = rho >> 4, i = rho & 15; return 8 * (i >> 2) + 4 * n + (i & 3); }

struct Unit { int pm, pn; };
struct Gemm { const bf16_t* A; const bf16_t* Bt; int M, N, K, lda, ldb, a_pn_stride; size_t a_tstep; };

struct StaticOrder {
    int nM, nN, nwg, G, c;
    __host__ __device__ __forceinline__ void init(int M, int N, int G_, int c_) { nM = M / BM; nN = N / BM; nwg = nM * nN; G = G_; c = c_; }
    __host__ __device__ __forceinline__ bool next(int i, Unit& u) const {
        const long L = (long)i * G + c; if (L >= nwg) return false;
        int wgid = (int)L; { const int q = nwg / NXCD, r = nwg % NXCD, xcd = wgid % NXCD, off = wgid / NXCD; wgid = (xcd < r ? xcd * (q + 1) : r * (q + 1) + (xcd - r) * q) + off; }
        const int nig = WGM * nN, gid = wgid / nig, fm = gid * WGM, gsz = (nM - fm) < WGM ? (nM - fm) : WGM;
        u.pm = fm + ((wgid % nig) % gsz); u.pn = (wgid % nig) / gsz; return true;
    }
    __device__ __forceinline__ void a_ready(const Unit&) const {}
    __device__ __forceinline__ void done(const Unit&) const {}
};

template <class Q> struct EpiQuad {
    static constexpr bool PERM = true, AFTER_DRAIN = false;
    Q q;
    __device__ __forceinline__ void operator()(const f32x4 (&acc)[2][2][4][2], const Unit& u, int wr, int wc, int fr, int fq) const {
        { const int ln = lane_now(); fr = ln & 15; fq = ln >> 4; }
        const int cin = wc * 32 + 8 * fq;
#pragma unroll
        for (int ai = 0; ai < 2; ++ai) {
            typename Q::Pre pre[4];
#pragma unroll
            for (int m = 0; m < 4; ++m) pre[m] = q.preload(u.pm * BM + ai * HALF + wr * 64 + m * 16 + fr, u.pn, cin);
#pragma unroll
            for (int m = 0; m < 4; ++m) {
                const int row = u.pm * BM + ai * HALF + wr * 64 + m * 16 + fr;
                q.quad(row, u.pn, cin, acc[ai][0][m][0], acc[ai][0][m][1], acc[ai][1][m][0], acc[ai][1][m][1], pre[m]);
            }
            __builtin_amdgcn_sched_barrier(0);
        }
    }
};

template <class Q, class = void> struct epi_deep { static constexpr bool value = false; };
template <class Q> struct epi_deep<Q, decltype((void)Q::DEEP)> { static constexpr bool value = Q::DEEP; };
template <class Q> struct EpiQuadStat {
    static constexpr bool PERM = true, AFTER_DRAIN = false;
    Q q; LAS float* P; int tid;
    __device__ __forceinline__ void operator()(const f32x4 (&acc)[2][2][4][2], const Unit& u, int wr, int wc, int fr, int fq) const {
        const int ln = lane_now(); fr = ln & 15; fq = ln >> 4;
        const int tl = (wr * 4 + wc) * 64 + ln;
        const int cin = wc * 32 + 8 * fq;
        LAS float* Pw = P + (wr * 64 + fr) * 4 + wc;
        bool done_deep = false;
        if constexpr (epi_deep<Q>::value) {
            if (q.deep_ok()) {
                done_deep = true;
                typename Q::PreRaw pr[2][4];
#pragma unroll
                for (int ai = 0; ai < 2; ++ai)
#pragma unroll
                    for (int m = 0; m < 4; ++m) pr[ai][m] = q.preload_raw(u.pm * BM + ai * HALF + wr * 64 + m * 16 + fr, u.pn, cin);
                __builtin_amdgcn_sched_barrier(0);
#pragma unroll
                for (int ai = 0; ai < 2; ++ai) {
#pragma unroll
                    for (int m = 0; m < 4; ++m) {
                        const int rl = ai * HALF + wr * 64 + m * 16 + fr;
                        float ss = q.quad_raw(u.pm * BM + rl, u.pn, cin, acc[ai][0][m][0], acc[ai][0][m][1], acc[ai][1][m][0], acc[ai][1][m][1], pr[ai][m]);
                        ss += xshfl<16>(ss); ss = sum32(ss);
                        if (fq == 0) Pw[(ai * HALF + m * 16) * 4] = ss;
                    }
                    __builtin_amdgcn_sched_barrier(0);
                }
            }
        }
        if (!done_deep)
#pragma unroll
        for (int ai = 0; ai < 2; ++ai) {
            typename Q::Pre pre[4];
#pragma unroll
            for (int m = 0; m < 4; ++m) pre[m] = q.preload(u.pm * BM + ai * HALF + wr * 64 + m * 16 + fr, u.pn, cin);
#pragma unroll
            for (int m = 0; m < 4; ++m) {
                const int rl = ai * HALF + wr * 64 + m * 16 + fr;
                float ss = q.quad(u.pm * BM + rl, u.pn, cin, acc[ai][0][m][0], acc[ai][0][m][1], acc[ai][1][m][0], acc[ai][1][m][1], pre[m]);
                ss += xshfl<16>(ss); ss = sum32(ss);
                if (fq == 0) Pw[(ai * HALF + m * 16) * 4] = ss;
            }
            __builtin_amdgcn_sched_barrier(0);
        }
        asm volatile("s_waitcnt lgkmcnt(0)" ::: "memory"); __builtin_amdgcn_s_barrier(); asm volatile("" ::: "memory");
        if (tl < 256) { const f32x4 p = *(const LAS f32x4*)(P + 4 * tl); q.put_stat(u.pm * BM + tl, u.pn, (p.x + p.y) + (p.z + p.w)); }
        asm volatile("s_waitcnt lgkmcnt(0)" ::: "memory");
    }
};

struct NoHook { __device__ __forceinline__ void operator()() const {} };
template <class Epi, class Sched, bool ALIGN_EPI = false, bool SP2 = false, class Hook = NoHook>
__device__ __forceinline__ void gemm_phase(LAS unsigned char* lds, const Gemm g, const Sched& S, const Epi& E, const int tid, const Hook& hook = Hook()) {
    const int wid = __builtin_amdgcn_readfirstlane(tid >> 6), lane = tid & 63, wr = wid >> 2, wc = wid & 3, fr = lane & 15, fq = lane >> 4;
    const int K = g.K, nt = K / BK;
    unsigned voffA[2], voffB[2];
#pragma unroll
    for (int i = 0; i < 2; ++i) { int R, C; stage_rc(tid * 16 + i * 8192, R, C); const int Rb = Epi::PERM ? ((R & ~31) + perm32(R & 31)) : R;
        voffA[i] = (unsigned)(R * g.lda + C) * 2u; voffB[i] = (unsigned)(Rb * g.ldb + C) * 2u; }
    const size_t kstep = (size_t)(BK * 2);
    const size_t hstepA = (size_t)HALF * g.lda * 2, hstepB = (size_t)HALF * g.ldb * 2;
    const size_t tstepA = g.a_tstep ? g.a_tstep : 2 * hstepA, tstepB = 2 * hstepB;
    const size_t pnA = (size_t)g.a_pn_stride * 2;
    const unsigned ldsw = (unsigned)wid * 1024u;
    const int aoff = lds_byte(wr * 64 + fr, fq * 8), boff = lds_byte(wc * 32 + fr, fq * 8);
#define PG8_SA(b, h) (((b) * 2 + (h)) * HTB)
#define PG8_SB(b, h) ((4 + (b) * 2 + (h)) * HTB)
    const __amdgpu_buffer_rsrc_t rsA = __builtin_amdgcn_make_buffer_rsrc((void*)g.A, 0, 0x7ffffffc, 0x00020000), rsB = __builtin_amdgcn_make_buffer_rsrc((void*)g.Bt, 0, 0x7ffffffc, 0x00020000);
    const char* const baseA = (const char*)g.A; const char* const baseB = (const char*)g.Bt;
#define PG8_STAGEA(bufoff, gbase, voff) do { _Pragma("unroll") for (int _i = 0; _i < 2; ++_i) \
        __builtin_amdgcn_raw_ptr_buffer_load_lds(rsA, (LAS void*)(lds + (bufoff) + ldsw + _i * 8192), 16, (voff)[_i], (unsigned)((const char*)(gbase) - baseA), 0, 0); } while (0)
#define PG8_STAGEB(bufoff, gbase, voff) do { _Pragma("unroll") for (int _i = 0; _i < 2; ++_i) \
        __builtin_amdgcn_raw_ptr_buffer_load_lds(rsB, (LAS void*)(lds + (bufoff) + ldsw + _i * 8192), 16, (voff)[_i], (unsigned)((const char*)(gbase) - baseB), 0, 0); } while (0)
#define PG8_LDA(dst, b, h) do { _Pragma("unroll") for (int m = 0; m < 4; ++m) _Pragma("unroll") for (int k = 0; k < 2; ++k) dst[m][k] = *(const LAS bf16x8*)(lds + PG8_SA(b, h) + aoff + m * 2048 + k * 1024); } while (0)
#define PG8_LDB(dst, b, h) do { _Pragma("unroll") for (int n = 0; n < 2; ++n) _Pragma("unroll") for (int k = 0; k < 2; ++k) dst[n][k] = *(const LAS bf16x8*)(lds + PG8_SB(b, h) + boff + n * 2048 + k * 1024); } while (0)
#define PG8_MMA(ai, bj, At, Bt) do { __builtin_amdgcn_s_setprio(1); _Pragma("unroll") for (int m = 0; m < 4; ++m) _Pragma("unroll") for (int n = 0; n < 2; ++n) _Pragma("unroll") for (int k = 0; k < 2; ++k) \
        acc[ai][bj][m][n] = __builtin_amdgcn_mfma_f32_16x16x32_bf16(Bt[n][k], At[m][k], acc[ai][bj][m][n], 0, 0, 0); __builtin_amdgcn_s_setprio(0); } while (0)
#define PG8_WAIT_V(n) asm volatile("s_waitcnt vmcnt(" #n ")" ::: "memory")
#define PG8_WAIT_L(n) asm volatile("s_waitcnt lgkmcnt(" #n ")" ::: "memory")
#define PG8_BAR __builtin_amdgcn_s_barrier()
#define PG8_SCHED __builtin_amdgcn_sched_barrier(0)
    Unit cur, nxt; int ui = 0;
    if (!S.next(0, cur)) return;
    f32x4 acc[2][2][4][2];
#pragma unroll
    for (int a = 0; a < 2; ++a)
#pragma unroll
        for (int b = 0; b < 2; ++b)
#pragma unroll
            for (int m = 0; m < 4; ++m)
#pragma unroll
                for (int n = 0; n < 2; ++n) acc[a][b][m][n] = (f32x4){0.f, 0.f, 0.f, 0.f};
    bf16x8 At[4][2], B0[2][2], B1[2][2];
    const char* cA = (const char*)g.A + (size_t)cur.pm * tstepA + (size_t)cur.pn * pnA; const char* cB = (const char*)g.Bt + (size_t)cur.pn * tstepB;
    S.a_ready(cur);
    if constexpr (SP2) {
        PG8_STAGEB(PG8_SB(0, 0), cB, voffB); PG8_STAGEB(PG8_SB(0, 1), cB + hstepB, voffB); PG8_STAGEA(PG8_SA(0, 0), cA, voffA); PG8_STAGEA(PG8_SA(0, 1), cA + hstepA, voffA);
        if (wr == 1) PG8_BAR;
        PG8_WAIT_V(2); hook(); PG8_BAR;
        PG8_STAGEB(PG8_SB(1, 0), cB + kstep, voffB); PG8_STAGEA(PG8_SA(1, 0), cA + kstep, voffA); PG8_STAGEB(PG8_SB(1, 1), cB + hstepB + kstep, voffB);
        PG8_WAIT_V(6); PG8_BAR;
    } else {
        PG8_STAGEB(PG8_SB(0, 0), cB, voffB); PG8_STAGEA(PG8_SA(0, 0), cA, voffA); PG8_STAGEB(PG8_SB(0, 1), cB + hstepB, voffB); PG8_STAGEA(PG8_SA(0, 1), cA + hstepA, voffA);
        if (wr == 1) PG8_BAR;
        PG8_WAIT_V(4); PG8_BAR;
        PG8_STAGEB(PG8_SB(1, 0), cB + kstep, voffB); PG8_STAGEA(PG8_SA(1, 0), cA + kstep, voffA); PG8_STAGEB(PG8_SB(1, 1), cB + hstepB + kstep, voffB);
        PG8_WAIT_V(6); PG8_BAR;
    }
    for (;;) {
        const bool has_next = S.next(ui + 1, nxt);
        const char* nA = has_next ? (const char*)g.A + (size_t)nxt.pm * tstepA + (size_t)nxt.pn * pnA : cA; const char* nB = has_next ? (const char*)g.Bt + (size_t)nxt.pn * tstepB : cB;
        for (int t = 0; t < nt; t += 2) {
            const bool last = (t == nt - 2);
            const char* a1 = cA + (size_t)(t + 1) * kstep;
            const char* a2 = last ? nA : cA + (size_t)(t + 2) * kstep; const char* b2 = last ? nB : cB + (size_t)(t + 2) * kstep;
            const char* a3 = a2 + kstep; const char* b3 = b2 + kstep;
            if (last && has_next) S.a_ready(nxt);
            if constexpr (SP2) {
            PG8_LDB(B0, 0, 0); PG8_LDB(B1, 0, 1); PG8_SCHED; PG8_LDA(At, 0, 0); PG8_STAGEA(PG8_SA(1, 1), a1 + hstepA, voffA);
            PG8_WAIT_V(8); PG8_WAIT_L(0); PG8_BAR; PG8_MMA(0, 0, At, B0); PG8_MMA(0, 1, At, B1); PG8_BAR; PG8_SCHED;
            PG8_LDA(At, 0, 1); PG8_STAGEB(PG8_SB(0, 0), b2, voffB); PG8_STAGEB(PG8_SB(0, 1), b2 + hstepB, voffB); PG8_STAGEA(PG8_SA(0, 0), a2, voffA);
            PG8_WAIT_V(8); PG8_WAIT_L(0); PG8_BAR; PG8_MMA(1, 0, At, B0); PG8_MMA(1, 1, At, B1); PG8_BAR; PG8_SCHED;
            PG8_LDB(B0, 1, 0); PG8_LDB(B1, 1, 1); PG8_SCHED; PG8_LDA(At, 1, 0); PG8_STAGEA(PG8_SA(0, 1), a2 + hstepA, voffA);
            PG8_WAIT_V(8); PG8_WAIT_L(0); PG8_BAR; PG8_MMA(0, 0, At, B0); PG8_MMA(0, 1, At, B1); PG8_BAR; PG8_SCHED;
            PG8_LDA(At, 1, 1); PG8_STAGEB(PG8_SB(1, 0), b3, voffB); PG8_STAGEB(PG8_SB(1, 1), b3 + hstepB, voffB); PG8_STAGEA(PG8_SA(1, 0), a3, voffA);
            PG8_WAIT_V(8); PG8_WAIT_L(0); PG8_BAR; PG8_MMA(1, 0, At, B0); PG8_MMA(1, 1, At, B1); PG8_BAR; PG8_SCHED;
            } else {
            PG8_LDB(B0, 0, 0); PG8_SCHED; PG8_LDA(At, 0, 0); PG8_STAGEA(PG8_SA(1, 1), a1 + hstepA, voffA);
            PG8_WAIT_L(8); PG8_BAR; PG8_WAIT_L(0); PG8_MMA(0, 0, At, B0); PG8_BAR; PG8_SCHED;
            PG8_LDB(B1, 0, 1); PG8_STAGEB(PG8_SB(0, 0), b2, voffB);
            PG8_BAR; PG8_WAIT_L(0); PG8_MMA(0, 1, At, B1); PG8_BAR;
            PG8_LDA(At, 0, 1); PG8_STAGEA(PG8_SA(0, 0), a2, voffA);
            PG8_BAR; PG8_WAIT_L(0); PG8_MMA(1, 0, At, B0); PG8_BAR; PG8_SCHED;
            PG8_STAGEB(PG8_SB(0, 1), b2 + hstepB, voffB);
            PG8_WAIT_V(6); PG8_BAR; PG8_MMA(1, 1, At, B1); PG8_BAR;
            PG8_LDB(B0, 1, 0); PG8_SCHED; PG8_LDA(At, 1, 0); PG8_STAGEA(PG8_SA(0, 1), a2 + hstepA, voffA);
            PG8_WAIT_L(8); PG8_BAR; PG8_WAIT_L(0); PG8_MMA(0, 0, At, B0); PG8_BAR; PG8_SCHED;
            PG8_LDB(B1, 1, 1); PG8_STAGEB(PG8_SB(1, 0), b3, voffB);
            PG8_BAR; PG8_WAIT_L(0); PG8_MMA(0, 1, At, B1); PG8_BAR;
            PG8_LDA(At, 1, 1); PG8_STAGEA(PG8_SA(1, 0), a3, voffA);
            PG8_BAR; PG8_WAIT_L(0); PG8_MMA(1, 0, At, B0); PG8_BAR; PG8_SCHED;
            PG8_STAGEB(PG8_SB(1, 1), b3 + hstepB, voffB);
            PG8_WAIT_V(6); PG8_BAR; PG8_MMA(1, 1, At, B1); PG8_BAR;
            }
        }
        if constexpr (ALIGN_EPI) { if (wr == 0) PG8_BAR; }
        if constexpr (!Epi::AFTER_DRAIN) { E(acc, cur, wr, wc, fr, fq); S.done(cur); }
        if (!has_next) break;
#pragma unroll
        for (int a = 0; a < 2; ++a)
#pragma unroll
            for (int b = 0; b < 2; ++b)
#pragma unroll
                for (int m = 0; m < 4; ++m)
#pragma unroll
                    for (int n = 0; n < 2; ++n) acc[a][b][m][n] = (f32x4){0.f, 0.f, 0.f, 0.f};
        cur = nxt; cA = nA; cB = nB; ++ui;
        if constexpr (ALIGN_EPI) { if (wr == 1) PG8_BAR; }
    }
    PG8_WAIT_V(0);
    if constexpr (!ALIGN_EPI) { if (wr == 0) PG8_BAR; }
    PG8_BAR;
    if constexpr (Epi::AFTER_DRAIN) { E.fused(acc, cur, wr, wc, fr, fq, lds, wid, lane); S.done(cur); }
#undef PG8_SA
#undef PG8_SB
#undef PG8_STAGEA
#undef PG8_STAGEB
#undef PG8_LDA
#undef PG8_LDB
#undef PG8_MMA
#undef PG8_WAIT_V
#undef PG8_WAIT_L
#undef PG8_BAR
#undef PG8_SCHED
}

}

struct QResidual {
    const float* xin_f32; float* xout_f32; bf16_t* xb; const float* bias; const float* scale; float* stat;
    const bf16_t* xsrc;
    struct Pre { f32x4 r[4]; };
    static constexpr bool HAS_RTAB = false;
    __device__ __forceinline__ Pre preload(int row, int pn, int cin) const {
        Pre o; const size_t off = (size_t)row * DM + 256 * pn + cin;
        if (xin_f32) { const float* p = xin_f32 + off; o.r[0] = *(const f32x4*)p; o.r[1] = *(const f32x4*)(p + 4); o.r[2] = *(const f32x4*)(p + 128); o.r[3] = *(const f32x4*)(p + 132); }
        else { const bf16_t* rs = xsrc ? xsrc : xb; const u32x4 h0 = *(const u32x4*)(rs + off), h1 = *(const u32x4*)(rs + off + 128);
            o.r[0] = (f32x4){bflo(h0[0]), bfhi(h0[0]), bflo(h0[1]), bfhi(h0[1])}; o.r[1] = (f32x4){bflo(h0[2]), bfhi(h0[2]), bflo(h0[3]), bfhi(h0[3])};
            o.r[2] = (f32x4){bflo(h1[0]), bfhi(h1[0]), bflo(h1[1]), bfhi(h1[1])}; o.r[3] = (f32x4){bflo(h1[2]), bfhi(h1[2]), bflo(h1[3]), bfhi(h1[3])}; }
        return o;
    }
    __device__ __forceinline__ float half(int row, int col, f32x4 v0, f32x4 v1, f32x4 r0, f32x4 r1) const {
        const size_t off = (size_t)row * DM + col;
        if (bias) {
            const f32x4 b0 = *(const f32x4*)(bias + col), b1 = *(const f32x4*)(bias + col + 4), s0 = *(const f32x4*)(scale + col), s1 = *(const f32x4*)(scale + col + 4);
            v0 = (v0 + b0) * s0; v1 = (v1 + b1) * s1;
        }
        v0 = v0 + r0; v1 = v1 + r1;
        if (xout_f32) { *(f32x4*)(xout_f32 + off) = v0; *(f32x4*)(xout_f32 + off + 4) = v1; }
        else *(u32x4*)(xb + off) = pack8(v0, v1);
        const f32x4 q0 = v0 * v0, q1 = v1 * v1; return ((q0.x + q0.y) + (q0.z + q0.w)) + ((q1.x + q1.y) + (q1.z + q1.w));
    }
    __device__ __forceinline__ float quad(int row, int pn, int cin, f32x4 a0, f32x4 a1, f32x4 b0, f32x4 b1, const Pre& p) const {
        return half(row, 256 * pn + cin, a0, a1, p.r[0], p.r[1]) + half(row, 256 * pn + 128 + cin, b0, b1, p.r[2], p.r[3]);
    }
    struct PreRaw { u32x4 h0, h1; };
    static constexpr bool DEEP = true;
    __device__ __forceinline__ bool deep_ok() const { return xin_f32 == nullptr; }
    __device__ __forceinline__ PreRaw preload_raw(int row, int pn, int cin) const {
        const size_t off = (size_t)row * DM + 256 * pn + cin; const bf16_t* rs = xsrc ? xsrc : xb;
        PreRaw o; o.h0 = *(const u32x4*)(rs + off); o.h1 = *(const u32x4*)(rs + off + 128); return o;
    }
    __device__ __forceinline__ float quad_raw(int row, int pn, int cin, f32x4 a0, f32x4 a1, f32x4 b0, f32x4 b1, const PreRaw& p) const {
        const u32x4 h0 = p.h0, h1 = p.h1;
        return half(row, 256 * pn + cin, a0, a1, (f32x4){bflo(h0[0]), bfhi(h0[0]), bflo(h0[1]), bfhi(h0[1])}, (f32x4){bflo(h0[2]), bfhi(h0[2]), bflo(h0[3]), bfhi(h0[3])})
             + half(row, 256 * pn + 128 + cin, b0, b1, (f32x4){bflo(h1[0]), bfhi(h1[0]), bflo(h1[1]), bfhi(h1[1])}, (f32x4){bflo(h1[2]), bfhi(h1[2]), bflo(h1[3]), bfhi(h1[3])});
    }
    __device__ __forceinline__ void put_stat(int row, int pn, float tot) const { stat[4 * (size_t)row + pn] = tot; }
};
typedef float f32x2 __attribute__((ext_vector_type(2)));
__device__ __forceinline__ f32x2 silu_mul2(f32x2 a, f32x2 b, float nr, float rr) {
    const f32x2 t = a * nr; f32x2 e; e.x = __builtin_amdgcn_exp2f(t.x); e.y = __builtin_amdgcn_exp2f(t.y);
    const f32x2 d = e + 1.0f; f32x2 rc; rc.x = __builtin_amdgcn_rcpf(d.x); rc.y = __builtin_amdgcn_rcpf(d.y);
    return (a * b) * (rc * rr);
}
struct QGateUp {
    bf16_t* hid; const float* stat;
    const LAS float* rtab; int tab_pm;
    static constexpr bool HAS_RTAB = true;
    __device__ __forceinline__ float rinv_global(int row) const { return row_rinv(stat, row, 1.0f / DM); }
    struct Pre { float r; };
    __device__ __forceinline__ Pre preload(int row, int, int) const { Pre o; o.r = (row >> 8) == tab_pm ? rtab[row & 255] : rinv_global(row); return o; }
    __device__ __forceinline__ float quad(int row, int pn, int cin, f32x4 a0, f32x4 a1, f32x4 b0, f32x4 b1, const Pre& pp) const {
        const float r = pp.r, nr = -1.4426950408889634f * r, rr = r * r;
        const f32x2 h00 = silu_mul2((f32x2){a0[0], a0[1]}, (f32x2){b0[0], b0[1]}, nr, rr), h01 = silu_mul2((f32x2){a0[2], a0[3]}, (f32x2){b0[2], b0[3]}, nr, rr);
        const f32x2 h10 = silu_mul2((f32x2){a1[0], a1[1]}, (f32x2){b1[0], b1[1]}, nr, rr), h11 = silu_mul2((f32x2){a1[2], a1[3]}, (f32x2){b1[2], b1[3]}, nr, rr);
        u32x4 w; w.x = cvt_pk_bf16(h00.x, h00.y); w.y = cvt_pk_bf16(h01.x, h01.y); w.z = cvt_pk_bf16(h10.x, h10.y); w.w = cvt_pk_bf16(h11.x, h11.y);
        *(u32x4*)(hid + (size_t)row * DFF + 128 * pn + cin) = w; return 0.f;
    }
};
constexpr size_t CKV_TSTEP = (size_t)256 * DFF, CKV_OFF = (size_t)256 * DM;
struct QKvd {
    bf16_t* ckvb; bf16_t* cqb; float* kpe; const float* stat; float* statc; float* statq; float* statpe;
    const LAS float* rtab; int tab_pm;
    static constexpr bool HAS_RTAB = true;
    __device__ __forceinline__ float rinv_global(int row) const { return row_rinv(stat, row, 1.0f / DM); }
    struct Pre { float r; };
    __device__ __forceinline__ Pre preload(int row, int, int) const { Pre o; o.r = (row >> 8) == tab_pm ? rtab[row & 255] : rinv_global(row); return o; }
    __device__ __forceinline__ float quad(int row, int pn, int cin, f32x4 a0, f32x4 a1, f32x4 b0, f32x4 b1, const Pre& pp) const {
        const float r = pp.r;
        a0 = a0 * r; a1 = a1 * r; b0 = b0 * r; b1 = b1 * r;
        if (pn < 2) { bf16_t* o = ckvb + (size_t)(row >> 8) * CKV_TSTEP + (size_t)(row & 255) * KVLR + 256 * pn + cin; *(u32x4*)o = pack8(a0, a1); *(u32x4*)(o + 128) = pack8(b0, b1); }
        else if (pn == 2) { bf16_t* o = cqb + (size_t)row * QLR + cin; *(u32x4*)o = pack8(a0, a1); *(u32x4*)(o + 128) = pack8(b0, b1); }
        else if (cin < DR) { float* o = kpe + (size_t)row * DR + cin; *(f32x4*)o = a0; *(f32x4*)(o + 4) = a1; }
        const f32x4 q0 = a0 * a0 + b0 * b0, q1 = a1 * a1 + b1 * b1; return ((q0.x + q0.y) + (q0.z + q0.w)) + ((q1.x + q1.y) + (q1.z + q1.w));
    }
    __device__ __forceinline__ void put_stat(int row, int pn, float tot) const {
        if (pn < 2) { statc[4 * (size_t)row + pn] = tot; statc[4 * (size_t)row + 2 + pn] = 0.f; }
        else if (pn == 2) *(f32x4*)(statq + 4 * (size_t)row) = (f32x4){tot, 0.f, 0.f, 0.f};
        else statpe[row] = tot;
    }
};
struct QRowScale {
    bf16_t* out; int ldc; const float* stat; float invn; float* stat_out;
    const LAS float* rtab; int tab_pm;
    static constexpr bool HAS_RTAB = true;
    __device__ __forceinline__ float rinv_global(int row) const { return row_rinv(stat, row, invn); }
    struct Pre { float r; };
    __device__ __forceinline__ Pre preload(int row, int, int) const { Pre o; o.r = (row >> 8) == tab_pm ? rtab[row & 255] : rinv_global(row); return o; }
    __device__ __forceinline__ float quad(int row, int pn, int cin, f32x4 a0, f32x4 a1, f32x4 b0, f32x4 b1, const Pre& pp) const {
        const float r = pp.r;
        bf16_t* o = out + (size_t)row * ldc + 256 * pn + cin;
        a0 = a0 * r; a1 = a1 * r; b0 = b0 * r; b1 = b1 * r;
        *(u32x4*)o = pack8(a0, a1); *(u32x4*)(o + 128) = pack8(b0, b1);
        const f32x4 q0 = a0 * a0 + b0 * b0, q1 = a1 * a1 + b1 * b1; return ((q0.x + q0.y) + (q0.z + q0.w)) + ((q1.x + q1.y) + (q1.z + q1.w));
    }
    __device__ __forceinline__ void put_stat(int row, int pn, float tot) const { if (stat_out) *(f32x4*)(stat_out + 4 * (size_t)row) = (f32x4){tot, 0.f, 0.f, 0.f}; }
};

constexpr int NWAVES = 8;
constexpr int RING_BYTES = 131072;
constexpr int KT_PITCH = 400, KT_BYTES = 64 * KT_PITCH, VT_PITCH = 320, VT_BYTES = 64 * VT_PITCH, KV_STAGE = KT_BYTES + VT_BYTES;
constexpr int WQI_HEAD = 32 * 192 * 16, WQ_OFF = KV_STAGE;
constexpr int ATT_OST = 2 * KV_STAGE, OST_PITCH = 264, OST_WAVE = 32 * OST_PITCH, ATT_LDS = ATT_OST + 8 * OST_WAVE;
constexpr int STATP_OFF = RING_BYTES;
constexpr int MISC_OFF = 159744 + 64, LDS_BYTES = 160 * 1024;
static_assert(ATT_LDS <= 159744 && MISC_OFF + 128 + 192 <= LDS_BYTES && STATP_OFF + 8192 <= MISC_OFF, "LDS map");
struct Frame {
    LAS unsigned char* lds; volatile LAS unsigned* MISC;
    int tid, lane, wave, vcu, G, gw, ngw;
};

enum { RM_PLAIN = 0, RM_GATE = 1, RM_UP = 2 };
__device__ __forceinline__ void prep_mat(const Frame& F, int& rot, const float* W, int ldsrc, int K, int ncols, int col0, const float* gain, bf16_t* WT, int mode, int row0) {
    LAS float* scr = (LAS float*)(F.lds + F.wave * 16384);
    const int lane = F.lane, nblk = ncols / 32, nitems = (K / 64) * nblk;
    const int first_ = (F.gw - rot + F.ngw) % F.ngw; rot = (rot + nitems) % F.ngw;
    for (int item = first_; item < nitems; item += 2 * F.ngw) {
        const int item2 = item + F.ngw; const bool two = item2 < nitems;
        float v[32], w[32];
        { const int kb = item / nblk, nb = item % nblk, k0 = 64 * kb, n0 = 32 * nb; const float* wp = W + (size_t)(k0 + (lane >> 5)) * ldsrc + col0 + n0 + (lane & 31);
#pragma unroll
          for (int i = 0; i < 32; ++i) v[i] = wp[(size_t)(2 * i) * ldsrc]; }
        if (two) { const int kb = item2 / nblk, nb = item2 % nblk, k0 = 64 * kb, n0 = 32 * nb; const float* wp = W + (size_t)(k0 + (lane >> 5)) * ldsrc + col0 + n0 + (lane & 31);
#pragma unroll
          for (int i = 0; i < 32; ++i) w[i] = wp[(size_t)(2 * i) * ldsrc]; }
#pragma unroll 1
        for (int rep = 0; rep < 2; ++rep) {
            if (rep == 1) { if (!two) break;
#pragma unroll
                for (int i = 0; i < 32; ++i) v[i] = w[i]; }
            const int it_ = rep == 0 ? item : item2, kb = it_ / nblk, nb = it_ % nblk, k0 = 64 * kb, n0 = 32 * nb;
            if (gain) {
                const float* gp = gain + k0 + (lane >> 5);
#pragma unroll
                for (int i = 0; i < 32; ++i) v[i] *= gp[2 * i];
            }
#pragma unroll
            for (int i = 0; i < 32; ++i) scr[(2 * i + (lane >> 5)) * 33 + (lane & 31)] = v[i];
            asm volatile("s_waitcnt lgkmcnt(0)" ::: "memory");
            const int c = lane & 7;
#pragma unroll
            for (int j = 0; j < 4; ++j) { const int nl = (lane >> 3) + 8 * j, n = n0 + nl; const LAS float* s = scr + (8 * c) * 33 + nl;
                u32x4 o; o.x = cvt_pk_bf16(s[0 * 33], s[1 * 33]); o.y = cvt_pk_bf16(s[2 * 33], s[3 * 33]); o.z = cvt_pk_bf16(s[4 * 33], s[5 * 33]); o.w = cvt_pk_bf16(s[6 * 33], s[7 * 33]);
                const int drow = mode == RM_PLAIN ? row0 + n : (256 * (n >> 7) + (n & 127) + (mode == RM_UP ? 128 : 0));
                *(u32x4*)(WT + (size_t)drow * K + k0 + 8 * c) = o; }
            asm volatile("s_waitcnt lgkmcnt(0)" ::: "memory");
        }
    }
}

struct PrepDesc { const float* W; int ldsrc, K, ncols; const float* gain; bf16_t* WT; int mode; };
__device__ __forceinline__ void prep_ld(const PrepDesc& d, int it, int lane, float (&v)[32]) {
    const int nblk = d.ncols / 32, kb = it / nblk, nb = it % nblk, k0 = 64 * kb, n0 = 32 * nb;
    const float* wp = d.W + (size_t)(k0 + (lane >> 5)) * d.ldsrc + n0 + (lane & 31);
#pragma unroll
    for (int i = 0; i < 32; ++i) v[i] = wp[(size_t)(2 * i) * d.ldsrc];
}
__device__ __forceinline__ void prep_fin(const PrepDesc& d, int it, int lane, LAS float* scr, float (&v)[32]) {
    const int nblk = d.ncols / 32, kb = it / nblk, nb = it % nblk, k0 = 64 * kb, n0 = 32 * nb;
    if (d.gain) {
        const float* gp = d.gain + k0 + (lane >> 5);
#pragma unroll
        for (int i = 0; i < 32; ++i) v[i] *= gp[2 * i];
    }
#pragma unroll
    for (int i = 0; i < 32; ++i) scr[(2 * i + (lane >> 5)) * 33 + (lane & 31)] = v[i];
    asm volatile("s_waitcnt lgkmcnt(0)" ::: "memory");
    const int c = lane & 7;
#pragma unroll
    for (int j = 0; j < 4; ++j) { const int nl = (lane >> 3) + 8 * j, n = n0 + nl; const LAS float* s = scr + (8 * c) * 33 + nl;
        u32x4 o; o.x = cvt_pk_bf16(s[0 * 33], s[1 * 33]); o.y = cvt_pk_bf16(s[2 * 33], s[3 * 33]); o.z = cvt_pk_bf16(s[4 * 33], s[5 * 33]); o.w = cvt_pk_bf16(s[6 * 33], s[7 * 33]);
        const int drow = d.mode == RM_PLAIN ? n : (256 * (n >> 7) + (n & 127) + (d.mode == RM_UP ? 128 : 0));
        *(u32x4*)(d.WT + (size_t)drow * d.K + k0 + 8 * c) = o; }
    asm volatile("s_waitcnt lgkmcnt(0)" ::: "memory");
}
__device__ __forceinline__ void prep_ffn(const Frame& F, int& rot, const float* wg, const float* wu, const float* wd, const float* lnf, bf16_t* wgu, bf16_t* wdn) {
    LAS float* scr = (LAS float*)(F.lds + F.wave * 16384);
    constexpr int PER = (DM / 64) * (DFF / 32), NIT = 3 * PER;
    static_assert((DFF / 64) * (DM / 32) == PER, "item counts");
    const int lane = F.lane;
    const int first_ = (F.gw - rot + F.ngw) % F.ngw; rot = (rot + NIT) % F.ngw;
#define PREP_DESC(m) ((m) == 0 ? PrepDesc{wg, DFF, DM, DFF, lnf, wgu, RM_GATE} : (m) == 1 ? PrepDesc{wu, DFF, DM, DFF, lnf, wgu, RM_UP} : PrepDesc{wd, DM, DFF, DM, nullptr, wdn, RM_PLAIN})
    for (int item = first_; item < NIT; item += 2 * F.ngw) {
        const int item2 = item + F.ngw; const bool two = item2 < NIT;
        const int ma = item / PER, ia = item % PER, mb = two ? item2 / PER : 0, ib = two ? item2 % PER : 0;
        const PrepDesc da = PREP_DESC(ma), db = PREP_DESC(mb);
        float v[32], w[32];
        prep_ld(da, ia, lane, v);
        if (two) prep_ld(db, ib, lane, w);
        prep_fin(da, ia, lane, scr, v);
        if (two) prep_fin(db, ib, lane, scr, w);
    }
#undef PREP_DESC
}
__device__ __forceinline__ void rowstat_x(const Frame& F, const float* x, float* stat) {
    for (int r0 = 8 * F.gw; r0 < M; r0 += 8 * F.ngw) {
        f32x4 v[8][4];
#pragma unroll
        for (int i = 0; i < 8; ++i) { const f32x4* p = (const f32x4*)(x + (size_t)(r0 + i) * DM) + F.lane;
#pragma unroll
            for (int j = 0; j < 4; ++j) v[i][j] = p[64 * j]; }
#pragma unroll
        for (int i = 0; i < 8; ++i) { float s = 0.f;
#pragma unroll
            for (int j = 0; j < 4; ++j) s += (v[i][j].x * v[i][j].x + v[i][j].y * v[i][j].y) + (v[i][j].z * v[i][j].z + v[i][j].w * v[i][j].w);
            s = wave_sum(s);
            if (F.lane == 0) *(f32x4*)(stat + 4 * (size_t)(r0 + i)) = (f32x4){s, 0.f, 0.f, 0.f}; }
    }
}
__device__ __forceinline__ float ld_as_f32(const float* p) { return *p; }
__device__ __forceinline__ float ld_as_f32(const bf16_t* p) { return bf2f((unsigned)*p); }
template <int W, class T> __device__ __forceinline__ void pool_load(const T* x, float (&xv)[32 + W - 1], int t0, int c) {
    const int pos0 = t0 & (SEQ - 1);
    const T* xp = x + (size_t)(t0 - (W - 1)) * DM + c;
#pragma unroll
    for (int i = 0; i < 32 + W - 1; ++i) xv[i] = (pos0 - (W - 1) + i >= 0) ? ld_as_f32(xp + (size_t)i * DM) : 0.f;
}
template <int W> __device__ __forceinline__ void pool_finish(float (&xv)[32 + W - 1], const LAS float* rt, float gc, bf16_t* dout, int t0, int c) {
    const int pos0 = t0 & (SEQ - 1);
#pragma unroll
    for (int i = 0; i < 32 + W - 1; ++i) xv[i] *= rt[16 - W + i];
    float ws[32 + W - 1];
#pragma unroll
    for (int i = 0; i < 32 + W - 1; ++i) ws[i] = xv[i];
#pragma unroll
    for (int w = 1; w < W; w *= 2) {
#pragma unroll
        for (int i = 32 + W - 2; i >= 2 * w - 1; --i) ws[i] += ws[i - w];
    }
#pragma unroll
    for (int i = 0; i < 32; ++i) {
        const int pos = pos0 + i; const float v = xv[i + W - 1];
        const int cnt = pos + 1 < W ? pos + 1 : W;
        const float d = (ws[i + W - 1] * (1.0f / (float)cnt) - v) * gc;
        dout[(size_t)(t0 + i) * DM + c] = (bf16_t)(cvt_pk_bf16(d, 0.f) & 0xffffu);
    }
}
template <int W, class T> __device__ __forceinline__ void pool_thread2(const T* x, const LAS float* rtA, const LAS float* rtB, const float* gain, bf16_t* dout, int tA, int tB, int c) {
    const float gc = gain[c];
    float xa[32 + W - 1], xb[32 + W - 1];
    pool_load<W, T>(x, xa, tA, c); pool_load<W, T>(x, xb, tB, c);
    pool_finish<W>(xa, rtA, gc, dout, tA, c); pool_finish<W>(xb, rtB, gc, dout, tB, c);
}
template <class T> __device__ __forceinline__ void pool_prep_unit(const Frame& F, const T* x, const float* stat, const float* gain, bf16_t* dout, int pm, int g) {
    LAS float* rt = (LAS float*)(F.lds + STATP_OFF);
    __syncthreads();
    if (F.tid < 271) { const int t = pm * 256 - 15 + F.tid; rt[F.tid] = ((pm & 15) != 0 || F.tid >= 15) ? row_rinv(stat, t, 1.0f / DM) : 0.f; }
    asm volatile("s_waitcnt lgkmcnt(0)" ::: "memory"); __syncthreads();
    const int c = g * 256 + (F.tid & 255);
#pragma unroll 1
    for (int q = 0; q < 2; ++q) {
        const int chA = 4 * q + (F.tid >> 8), chB = chA + 2, tA = pm * 256 + chA * 32, tB = pm * 256 + chB * 32; const LAS float* rA = rt + chA * 32; const LAS float* rB = rt + chB * 32;
        if (g == 0) pool_thread2<2, T>(x, rA, rB, gain, dout, tA, tB, c);
        else if (g == 1) pool_thread2<4, T>(x, rA, rB, gain, dout, tA, tB, c);
        else if (g == 2) pool_thread2<8, T>(x, rA, rB, gain, dout, tA, tB, c);
        else pool_thread2<16, T>(x, rA, rB, gain, dout, tA, tB, c);
    }
}

__device__ __forceinline__ void rope_cs(int pos, int i, float& c, float& s) {
    const float inv = __builtin_amdgcn_exp2f(-(float)i * 0.41524101186092f);
    const float ang = (float)pos * inv;
    const float n = rintf(ang * 0.15915494309189535f);
    float r = fmaf(-n, 6.2831854820251465f, ang); r = fmaf(-n, -1.7484556000744883e-07f, r);
    const float rv = r * 0.15915494309189535f;
    c = __builtin_amdgcn_cosf(rv); s = __builtin_amdgcn_sinf(rv);
}

__device__ __forceinline__ void finalize_q(const Frame& F, bf16_t* q, const float* g_q, const int* positions) {
    LAS float* scr = (LAS float*)(F.lds + F.wave * 16384); const int l = F.lane;
    for (int t = F.gw; t < M; t += F.ngw) {
        const int pos = positions[t];
        bf16_t* row = q + (size_t)t * (NH * DQK) + 24 * l;
        const u32x4 w0 = *(const u32x4*)row, w1 = *(const u32x4*)(row + 8), w2 = *(const u32x4*)(row + 16);
        float v[24];
#pragma unroll
        for (int i = 0; i < 4; ++i) { v[2 * i] = bflo(w0[i]); v[2 * i + 1] = bfhi(w0[i]); v[8 + 2 * i] = bflo(w1[i]); v[8 + 2 * i + 1] = bfhi(w1[i]); v[16 + 2 * i] = bflo(w2[i]); v[16 + 2 * i + 1] = bfhi(w2[i]); }
        float ss = 0.f;
#pragma unroll
        for (int i = 0; i < 24; ++i) ss += v[i] * v[i];
        ss += xshfl<1>(ss); ss += xshfl<2>(ss); ss += xshfl<4>(ss);
        const float rq = rsqrtf(ss * (1.0f / DQK) + EPS) * QSCALE;
        const int c0 = 24 * (l & 7);
#pragma unroll
        for (int i = 0; i < 24; ++i) scr[24 * l + i] = v[i] * rq * g_q[c0 + i];
        asm volatile("s_waitcnt lgkmcnt(0)" ::: "memory");
        const int i = l & 31; float c, sn; rope_cs(pos, i, c, sn);
#pragma unroll
        for (int p = 0; p < 4; ++p) { const int pid = l + 64 * p, h = pid >> 5; LAS float* a = scr + DQK * h + DN + i; const float x1 = a[0], x2 = a[32];
            a[0] = x1 * c - x2 * sn; a[32] = x2 * c + x1 * sn; }
        asm volatile("s_waitcnt lgkmcnt(0)" ::: "memory");
        f32x4 o[6];
#pragma unroll
        for (int k = 0; k < 6; ++k) o[k] = *(const LAS f32x4*)(scr + 24 * l + 4 * k);
        *(u32x4*)row = pack8(o[0], o[1]); *(u32x4*)(row + 8) = pack8(o[2], o[3]); *(u32x4*)(row + 16) = pack8(o[4], o[5]);
        asm volatile("s_waitcnt lgkmcnt(0)" ::: "memory");
    }
}

__device__ __forceinline__ int crow(int r, int hi) { return (r & 3) + 8 * (r >> 2) + 4 * hi; }
__device__ __forceinline__ void attn_simple_unit(const bf16_t* Q, const bf16_t* Kf, const bf16_t* Vt, bf16_t* O, int bh, int qw, int lane) {
    const int c = lane & 31, hi = lane >> 5, b = bh / NH, h = bh % NH;
    const bf16_t* qp = Q + (size_t)(b * SEQ + 32 * qw + c) * (NH * DQK) + h * DQK + 8 * hi;
    bf16x8 qf[12];
#pragma unroll
    for (int st = 0; st < 12; ++st) qf[st] = *(const bf16x8*)(qp + 16 * st);
    f32x16 o[4];
#pragma unroll
    for (int d = 0; d < 4; ++d) o[d] = (f32x16){};
    float m = -1e30f, lsum = 0.f;
    const int nkb = 2 * ((qw >> 1) + 1);
    const bf16_t* kbase = Kf + (size_t)bh * SEQ * (KT_PITCH / 2) + (size_t)c * (KT_PITCH / 2) + 8 * hi;
    const bf16_t* vbase = Vt + (size_t)bh * SEQ * (VT_PITCH / 2) + c;
    for (int kb = 0; kb < nkb; ++kb) {
        f32x16 sacc = (f32x16){};
        const bf16_t* kp = kbase + (size_t)(32 * kb) * (KT_PITCH / 2);
#pragma unroll
        for (int st = 0; st < 12; ++st) { const bf16x8 kf = *(const bf16x8*)(kp + 16 * st); sacc = __builtin_amdgcn_mfma_f32_32x32x16_bf16(kf, qf[st], sacc, 0, 0, 0); }
        float mx = sacc[0];
#pragma unroll
        for (int r = 1; r < 16; ++r) mx = fmaxf(mx, sacc[r]);
        mx = max32(mx);
        const float mn = fmaxf(m, mx), alpha = __builtin_amdgcn_exp2f(m - mn);
        float ps = 0.f;
#pragma unroll
        for (int r = 0; r < 16; ++r) { sacc[r] = __builtin_amdgcn_exp2f(sacc[r] - mn); ps += sacc[r]; }
        ps = sum32(ps);
        lsum = lsum * alpha + ps; m = mn;
#pragma unroll
        for (int d = 0; d < 4; ++d)
#pragma unroll
            for (int r = 0; r < 16; ++r) o[d][r] *= alpha;
        bf16x8 pb[2];
#pragma unroll
        for (int s2 = 0; s2 < 2; ++s2) { u32x4 w; w.x = cvt_pk_bf16(sacc[8 * s2 + 0], sacc[8 * s2 + 1]); w.y = cvt_pk_bf16(sacc[8 * s2 + 2], sacc[8 * s2 + 3]); w.z = cvt_pk_bf16(sacc[8 * s2 + 4], sacc[8 * s2 + 5]); w.w = cvt_pk_bf16(sacc[8 * s2 + 6], sacc[8 * s2 + 7]);
            pb[s2] = __builtin_bit_cast(bf16x8, w); }
#pragma unroll
        for (int d = 0; d < 4; ++d)
#pragma unroll
            for (int s2 = 0; s2 < 2; ++s2) { bf16x8 vf;
#pragma unroll
                for (int j = 0; j < 8; ++j) vf[j] = (short)vbase[(size_t)(32 * kb + 16 * s2 + 8 * (j >> 2) + 4 * hi + (j & 3)) * (VT_PITCH / 2) + 32 * d];
                o[d] = __builtin_amdgcn_mfma_f32_32x32x16_bf16(vf, pb[s2], o[d], 0, 0, 0); }
    }
    const float rl = 1.0f / lsum;
    bf16_t* op = O + (size_t)(b * SEQ + 32 * qw + c) * DM + h * DV;
#pragma unroll
    for (int d = 0; d < 4; ++d)
#pragma unroll
        for (int g = 0; g < 4; ++g) { u32x2 w; w.x = cvt_pk_bf16(o[d][4 * g] * rl, o[d][4 * g + 1] * rl); w.y = cvt_pk_bf16(o[d][4 * g + 2] * rl, o[d][4 * g + 3] * rl);
            *(u32x2*)(op + 32 * d + 8 * g + 4 * hi) = w; }
}
__device__ __forceinline__ void attn_simple(const Frame& F, const bf16_t* Q, const bf16_t* Kf, const bf16_t* Vt, bf16_t* O) {
    for (int w = F.gw; w < BATCH * NH * 64; w += F.ngw) {
        const int bh = w >> 6, i = w & 63;
        attn_simple_unit(Q, Kf, Vt, O, bh, 127 - i, F.lane);
        attn_simple_unit(Q, Kf, Vt, O, bh, i, F.lane);
    }
}

__device__ __forceinline__ void prep_wqimg(const Frame& F, const bf16_t* wuq_t, bf16_t* wqi) {
    for (int e = F.gw * 64 + F.lane; e < 2 * NH * 32 * 192; e += F.ngw * 64) {
        const int ip = e % 192, kc = (e / 192) % 32, jh = e / (192 * 32), i = ip & 31, b6 = ip >> 5;
        const int dim = 32 * b6 + 16 * (i >> 4) + 8 * ((i >> 2) & 1) + 4 * ((i >> 3) & 1) + (i & 3);
        *(u32x4*)(wqi + (size_t)e * 8) = *(const u32x4*)(wuq_t + ((size_t)jh * 192 + dim) * QLR + 8 * kc);
    }
}
constexpr float ATT_BMAX = 48.0f;
constexpr size_t OSLOT_ELEMS = (size_t)256 * DFF;
#define ATT_MAP16 true
#define ATT_DESC2 true
#define ATT_SB() __builtin_amdgcn_sched_barrier(0)
typedef short s16x4_t __attribute__((ext_vector_type(4)));
typedef short v4i16_t __attribute__((ext_vector_type(4)));
__device__ __forceinline__ void attn_qk(const LAS unsigned char* kb, const bf16x8 (&qf)[12], bf16x8 (&pb)[4], float& lsum) {
    f32x16 p0, p1;
    bf16x8 ka[2][2];
#define ATT_KLD(bf, st) do { ka[bf][0] = *(const LAS bf16x8*)(kb + (st) * 32); ka[bf][1] = *(const LAS bf16x8*)(kb + 32 * KT_PITCH + (st) * 32); } while (0)
    ATT_KLD(0, 0); ATT_SB();
#pragma unroll
    for (int st = 0; st < 12; ++st) {
        if (st < 11) ATT_KLD((st + 1) & 1, st + 1);
        __builtin_amdgcn_s_setprio(1);
        if (st == 0) { p0 = __builtin_amdgcn_mfma_f32_32x32x16_bf16(ka[0][0], qf[0], (f32x16){}, 0, 0, 0); p1 = __builtin_amdgcn_mfma_f32_32x32x16_bf16(ka[0][1], qf[0], (f32x16){}, 0, 0, 0); }
        else { p0 = __builtin_amdgcn_mfma_f32_32x32x16_bf16(ka[st & 1][0], qf[st], p0, 0, 0, 0); p1 = __builtin_amdgcn_mfma_f32_32x32x16_bf16(ka[st & 1][1], qf[st], p1, 0, 0, 0); }
        __builtin_amdgcn_s_setprio(0);
        ATT_SB();
    }
#undef ATT_KLD
    float sa = 0.f, sb = 0.f;
#pragma unroll
    for (int r = 0; r < 16; ++r) { p0[r] = __builtin_amdgcn_exp2f(p0[r]); p1[r] = __builtin_amdgcn_exp2f(p1[r]); sa += p0[r]; sb += p1[r]; }
    lsum += sa + sb;
#pragma unroll
    for (int s2 = 0; s2 < 2; ++s2) {
        u32x4 w; w.x = cvt_pk_bf16(p0[8 * s2 + 0], p0[8 * s2 + 1]); w.y = cvt_pk_bf16(p0[8 * s2 + 2], p0[8 * s2 + 3]); w.z = cvt_pk_bf16(p0[8 * s2 + 4], p0[8 * s2 + 5]); w.w = cvt_pk_bf16(p0[8 * s2 + 6], p0[8 * s2 + 7]);
        pb[s2] = __builtin_bit_cast(bf16x8, w);
        u32x4 v; v.x = cvt_pk_bf16(p1[8 * s2 + 0], p1[8 * s2 + 1]); v.y = cvt_pk_bf16(p1[8 * s2 + 2], p1[8 * s2 + 3]); v.z = cvt_pk_bf16(p1[8 * s2 + 4], p1[8 * s2 + 5]); v.w = cvt_pk_bf16(p1[8 * s2 + 6], p1[8 * s2 + 7]);
        pb[2 + s2] = __builtin_bit_cast(bf16x8, v);
    }
}
__device__ __forceinline__ void attn_pv(const LAS unsigned char* vb, const bf16x8 (&pb)[4], f32x16 (&o)[4]) {
    const unsigned va_ = (unsigned)(size_t)vb;
    s16x4_t r[2][4];
#define ATT_TRR(dst, off) asm volatile("ds_read_b64_tr_b16 %0, %1 offset:%2" : "=v"(dst) : "v"(va_), "i"(off))
#define ATT_VLD(bf, c) do { ATT_TRR(r[bf][0], (32 * ((c) & 1)) * VT_PITCH + ((c) >> 1) * 64); ATT_TRR(r[bf][1], (32 * ((c) & 1) + 8) * VT_PITCH + ((c) >> 1) * 64); \
                            ATT_TRR(r[bf][2], (32 * ((c) & 1) + 16) * VT_PITCH + ((c) >> 1) * 64); ATT_TRR(r[bf][3], (32 * ((c) & 1) + 24) * VT_PITCH + ((c) >> 1) * 64); } while (0)
    ATT_VLD(0, 0);
#pragma unroll
    for (int cidx = 0; cidx < 8; ++cidx) {
        if (cidx < 7) { ATT_VLD((cidx + 1) & 1, cidx + 1); asm volatile("s_waitcnt lgkmcnt(4)" : "+v"(r[cidx & 1][0]), "+v"(r[cidx & 1][1]), "+v"(r[cidx & 1][2]), "+v"(r[cidx & 1][3])); }
        else asm volatile("s_waitcnt lgkmcnt(0)" : "+v"(r[cidx & 1][0]), "+v"(r[cidx & 1][1]), "+v"(r[cidx & 1][2]), "+v"(r[cidx & 1][3]));
        ATT_SB();
        const bf16x8 f0 = __builtin_shufflevector(r[cidx & 1][0], r[cidx & 1][1], 0, 1, 2, 3, 4, 5, 6, 7), f1 = __builtin_shufflevector(r[cidx & 1][2], r[cidx & 1][3], 0, 1, 2, 3, 4, 5, 6, 7);
        __builtin_amdgcn_s_setprio(1);
        o[cidx >> 1] = __builtin_amdgcn_mfma_f32_32x32x16_bf16(f0, pb[2 * (cidx & 1)], o[cidx >> 1], 0, 0, 0);
        o[cidx >> 1] = __builtin_amdgcn_mfma_f32_32x32x16_bf16(f1, pb[2 * (cidx & 1) + 1], o[cidx >> 1], 0, 0, 0);
        __builtin_amdgcn_s_setprio(0);
        ATT_SB();
    }
#undef ATT_VLD
#undef ATT_TRR
}

__device__ __forceinline__ void attn_tile(const LAS unsigned char* kb, const LAS unsigned char* vb, const bf16x8 (&qf)[12], f32x16 (&o)[4], float& lsum) {
    f32x16 p0, p1;
    bf16x8 ka[2];
    f32x2 s2acc = {0.f, 0.f};
    u32x4 pw[4];
#define ATT_KLD(bf, half, st) ka[bf] = *(const LAS bf16x8*)(kb + (half) * 32 * KT_PITCH + (st) * 32)
    ATT_KLD(0, 0, 0); ATT_SB();
#pragma unroll
    for (int st = 0; st < 12; ++st) {
        if (st < 11) ATT_KLD((st + 1) & 1, 0, st + 1); else ATT_KLD(0, 1, 0);
        if (st == 0) p0 = __builtin_amdgcn_mfma_f32_32x32x16_bf16(ka[0], qf[0], (f32x16){}, 0, 0, 0); else p0 = __builtin_amdgcn_mfma_f32_32x32x16_bf16(ka[st & 1], qf[st], p0, 0, 0, 0);
        ATT_SB();
    }
#pragma unroll
    for (int st = 0; st < 12; ++st) {
        if (st < 11) ATT_KLD((st + 1) & 1, 1, st + 1);
        if (st == 0) p1 = __builtin_amdgcn_mfma_f32_32x32x16_bf16(ka[0], qf[0], (f32x16){}, 0, 0, 0); else p1 = __builtin_amdgcn_mfma_f32_32x32x16_bf16(ka[st & 1], qf[st], p1, 0, 0, 0);
        ATT_SB();
        if (st < 8) { p0[2 * st] = __builtin_amdgcn_exp2f(p0[2 * st]); p0[2 * st + 1] = __builtin_amdgcn_exp2f(p0[2 * st + 1]); }
        else { const int j_ = st - 8, b_ = 4 * j_; s2acc += (f32x2){p0[b_], p0[b_ + 1]}; s2acc += (f32x2){p0[b_ + 2], p0[b_ + 3]};
            pw[j_ >> 1][2 * (j_ & 1)] = cvt_pk_bf16(p0[b_], p0[b_ + 1]); pw[j_ >> 1][2 * (j_ & 1) + 1] = cvt_pk_bf16(p0[b_ + 2], p0[b_ + 3]); }
        ATT_SB();
    }
#undef ATT_KLD
    const unsigned va_ = (unsigned)(size_t)vb;
    s16x4_t r[2][4];
#define ATT_TRR(dst, off) asm volatile("ds_read_b64_tr_b16 %0, %1 offset:%2" : "=v"(dst) : "v"(va_), "i"(off))
#define ATT_VLD(bf, c) do { ATT_TRR(r[bf][0], (32 * ((c) & 1)) * VT_PITCH + ((c) >> 1) * 64); ATT_TRR(r[bf][1], (32 * ((c) & 1) + 8) * VT_PITCH + ((c) >> 1) * 64); \
                            ATT_TRR(r[bf][2], (32 * ((c) & 1) + 16) * VT_PITCH + ((c) >> 1) * 64); ATT_TRR(r[bf][3], (32 * ((c) & 1) + 24) * VT_PITCH + ((c) >> 1) * 64); } while (0)
#define ATT_CH(i) (2 * ((i) & 3) + ((i) >> 2))
    ATT_VLD(0, ATT_CH(0));
#pragma unroll
    for (int i = 0; i < 8; ++i) {
        const int cidx = ATT_CH(i);
        if (i < 7) { ATT_VLD((i + 1) & 1, ATT_CH(i + 1)); asm volatile("s_waitcnt lgkmcnt(4)" : "+v"(r[i & 1][0]), "+v"(r[i & 1][1]), "+v"(r[i & 1][2]), "+v"(r[i & 1][3])); }
        else asm volatile("s_waitcnt lgkmcnt(0)" : "+v"(r[i & 1][0]), "+v"(r[i & 1][1]), "+v"(r[i & 1][2]), "+v"(r[i & 1][3]));
        ATT_SB();
        const bf16x8 f0 = __builtin_shufflevector(r[i & 1][0], r[i & 1][1], 0, 1, 2, 3, 4, 5, 6, 7), f1 = __builtin_shufflevector(r[i & 1][2], r[i & 1][3], 0, 1, 2, 3, 4, 5, 6, 7);
        o[cidx >> 1] = __builtin_amdgcn_mfma_f32_32x32x16_bf16(f0, __builtin_bit_cast(bf16x8, pw[2 * (cidx & 1)]), o[cidx >> 1], 0, 0, 0);
        ATT_SB();
        if (i < 4) { p1[4 * i] = __builtin_amdgcn_exp2f(p1[4 * i]); p1[4 * i + 1] = __builtin_amdgcn_exp2f(p1[4 * i + 1]); ATT_SB(); }
        o[cidx >> 1] = __builtin_amdgcn_mfma_f32_32x32x16_bf16(f1, __builtin_bit_cast(bf16x8, pw[2 * (cidx & 1) + 1]), o[cidx >> 1], 0, 0, 0);
        ATT_SB();
        if (i < 4) { p1[4 * i + 2] = __builtin_amdgcn_exp2f(p1[4 * i + 2]); p1[4 * i + 3] = __builtin_amdgcn_exp2f(p1[4 * i + 3]); ATT_SB(); }
        if (i == 3) {
#pragma unroll
            for (int j_ = 0; j_ < 4; ++j_) { const int b_ = 4 * j_; s2acc += (f32x2){p1[b_], p1[b_ + 1]}; s2acc += (f32x2){p1[b_ + 2], p1[b_ + 3]};
                pw[2 + (j_ >> 1)][2 * (j_ & 1)] = cvt_pk_bf16(p1[b_], p1[b_ + 1]); pw[2 + (j_ >> 1)][2 * (j_ & 1) + 1] = cvt_pk_bf16(p1[b_ + 2], p1[b_ + 3]); }
            ATT_SB();
        }
    }
#undef ATT_CH
#undef ATT_VLD
#undef ATT_TRR
    lsum += s2acc.x + s2acc.y;
}
__device__ __forceinline__ void attn_dma_k(LAS unsigned char* lds, const bf16_t* kimg, int bh, int tile, int stage, int wid, int lane) {
    const __amdgpu_buffer_rsrc_t rs = __builtin_amdgcn_make_buffer_rsrc((void*)kimg, 0, 0x7ffffffc, 0x00020000);
    const unsigned so = (unsigned)(bh * (SEQ / 64) + tile) * (unsigned)KT_BYTES;
    LAS unsigned char* kd = lds + stage * KV_STAGE;
    for (int pc = wid; pc < KT_BYTES / 1024; pc += 8) __builtin_amdgcn_raw_ptr_buffer_load_lds(rs, (LAS void*)(kd + pc * 1024), 16, lane * 16, so + pc * 1024, 0, 0);
}
__device__ __forceinline__ void attn_dma_v(LAS unsigned char* lds, const bf16_t* vimg, int bh, int tile, int stage, int wid, int lane) {
    const __amdgpu_buffer_rsrc_t rs = __builtin_amdgcn_make_buffer_rsrc((void*)vimg, 0, 0x7ffffffc, 0x00020000);
    const unsigned so = (unsigned)(bh * (SEQ / 64) + tile) * (unsigned)VT_BYTES;
    LAS unsigned char* vd = lds + stage * KV_STAGE + KT_BYTES;
    for (int pc = 7 - wid; pc < VT_BYTES / 1024; pc += 8) __builtin_amdgcn_raw_ptr_buffer_load_lds(rs, (LAS void*)(vd + pc * 1024), 16, lane * 16, so + pc * 1024, 0, 0);
}
__device__ __forceinline__ void attn_wait_vm(int n) {
    if (n == 0) asm volatile("s_waitcnt vmcnt(0)" ::: "memory"); else if (n == 1) asm volatile("s_waitcnt vmcnt(1)" ::: "memory"); else if (n == 2) asm volatile("s_waitcnt vmcnt(2)" ::: "memory");
    else if (n == 3) asm volatile("s_waitcnt vmcnt(3)" ::: "memory"); else asm volatile("s_waitcnt vmcnt(4)" ::: "memory");
}
__device__ __forceinline__ void attn_unit(const Frame& F, const bf16_t* cq, const float* statq, const bf16_t* wqi, const bf16_t* kimg, const bf16_t* vimg, bf16_t* O, const float* g_q, const int* positions, int bh, int qb, bool desc) {
    int lane_ = F.lane; asm volatile("" : "+v"(lane_));
    const int lane = lane_, wid = F.wave, c = lane & 31, hi = lane >> 5, b = bh / NH, h = bh % NH;
    const int NT = 4 * qb + 4, tmax = 4 * qb + (wid >> 1);
    __builtin_amdgcn_s_barrier();
    const int t0 = desc ? NT - 1 : 0, dt = desc ? -1 : 1;
    attn_dma_k(F.lds, kimg, bh, t0, 0, wid, lane); attn_dma_v(F.lds, vimg, bh, t0, 0, wid, lane);
    {
        const __amdgpu_buffer_rsrc_t rs = __builtin_amdgcn_make_buffer_rsrc((void*)wqi, 0, 0x7ffffffc, 0x00020000); LAS unsigned char* wd = F.lds + WQ_OFF;
        for (int pc = wid; pc < WQI_HEAD / 1024; pc += 8) __builtin_amdgcn_raw_ptr_buffer_load_lds(rs, (LAS void*)(wd + pc * 1024), 16, lane * 16, (unsigned)h * WQI_HEAD + pc * 1024, 0, 0);
    }
    bf16x8 qf[12];
    {
        const int row = b * SEQ + 256 * qb + 32 * wid + c;
        const bf16_t* cp = cq + (size_t)row * QLR + 8 * hi;
        bf16x8 cf[16];
#pragma unroll
        for (int ks = 0; ks < 16; ++ks) cf[ks] = *(const bf16x8*)(cp + 16 * ks);
        const float rlat = row_rinv(statq, row, 1.0f / QLR);
        const int pos = positions[row];
        int hir = hi; asm volatile("" : "+v"(hir));
        asm volatile("s_waitcnt vmcnt(0)" ::: "memory"); __builtin_amdgcn_s_barrier(); asm volatile("" ::: "memory");
        f32x16 qa[6];
#pragma unroll
        for (int b6 = 0; b6 < 6; ++b6) qa[b6] = (f32x16){};
        const LAS unsigned char* wl = F.lds + WQ_OFF + (hi * 192 + c) * 16;
#pragma unroll
        for (int ks = 0; ks < 16; ++ks) {
            bf16x8 wa[6];
#pragma unroll
            for (int b6 = 0; b6 < 6; ++b6) wa[b6] = *(const LAS bf16x8*)(wl + (2 * ks * 192 + 32 * b6) * 16);
#pragma unroll
            for (int b6 = 0; b6 < 6; ++b6) qa[b6] = __builtin_amdgcn_mfma_f32_32x32x16_bf16(wa[b6], cf[ks], qa[b6], 0, 0, 0);
            __builtin_amdgcn_sched_barrier(0);
        }
        float ss = 0.f;
#pragma unroll
        for (int b6 = 0; b6 < 6; ++b6)
#pragma unroll
            for (int r = 0; r < 16; ++r) ss += qa[b6][r] * qa[b6][r];
        { const auto rr = __builtin_amdgcn_permlane32_swap(__float_as_uint(ss), __float_as_uint(ss), false, false); ss = __uint_as_float(rr[0]) + __uint_as_float(rr[1]); }
        const float rq = rlat * rsqrtf(ss * (rlat * rlat * (1.0f / DQK)) + EPS) * QSCALE;
        const float* gq = g_q + 8 * hir;
#pragma unroll
        for (int st = 0; st < 8; ++st) { const f32x4 g0 = *(const f32x4*)(gq + 16 * st), g1 = *(const f32x4*)(gq + 16 * st + 4); const int o8 = 8 * (st & 1);
            const f32x4 v0 = {qa[st >> 1][o8 + 0], qa[st >> 1][o8 + 1], qa[st >> 1][o8 + 2], qa[st >> 1][o8 + 3]}, v1 = {qa[st >> 1][o8 + 4], qa[st >> 1][o8 + 5], qa[st >> 1][o8 + 6], qa[st >> 1][o8 + 7]};
            qf[st] = __builtin_bit_cast(bf16x8, pack8(v0 * g0 * rq, v1 * g1 * rq)); }
#pragma unroll
        for (int st = 8; st < 10; ++st) {
            float xa[8], xb2[8];
#pragma unroll
            for (int e = 0; e < 8; ++e) { xa[e] = qa[4][8 * (st & 1) + e]; xb2[e] = qa[5][8 * (st & 1) + e]; }
            f32x4 oa[2], ob[2];
#pragma unroll
            for (int e = 0; e < 8; ++e) {
                const int i = 16 * (st - 8) + 8 * hir + e; float cs, sn; rope_cs(pos, i, cs, sn);
                const float x1 = xa[e] * rq * gq[16 * st + e], x2 = xb2[e] * rq * gq[16 * (st + 2) + e];
                oa[e >> 2][e & 3] = x1 * cs - x2 * sn; ob[e >> 2][e & 3] = x2 * cs + x1 * sn;
            }
            qf[st] = __builtin_bit_cast(bf16x8, pack8(oa[0], oa[1])); qf[st + 2] = __builtin_bit_cast(bf16x8, pack8(ob[0], ob[1]));
            __builtin_amdgcn_sched_barrier(0);
        }
    }
    __builtin_amdgcn_sched_barrier(0);
    f32x16 o[4];
#pragma unroll
    for (int d = 0; d < 4; ++d) o[d] = (f32x16){};
    float lsum = 0.f;
    const int kro = c * KT_PITCH + hi * 16, vro = KT_BYTES + (4 * hi + ((lane & 15) >> 2)) * VT_PITCH + 32 * ((lane >> 4) & 1) + 8 * (lane & 3);
    for (int i = 0; i < NT; ++i) {
        const int t = t0 + dt * i;
        asm volatile("s_waitcnt vmcnt(0)" ::: "memory"); __builtin_amdgcn_s_barrier(); asm volatile("" ::: "memory");
        if (i + 1 < NT) { attn_dma_k(F.lds, kimg, bh, t + dt, (i + 1) & 1, wid, lane); attn_dma_v(F.lds, vimg, bh, t + dt, (i + 1) & 1, wid, lane); }
        if (t <= tmax) {
            const LAS unsigned char* sb = F.lds + (i & 1) * KV_STAGE;
            attn_tile(sb + kro, sb + vro, qf, o, lsum);
        }
    }
    { const auto rr = __builtin_amdgcn_permlane32_swap(__float_as_uint(lsum), __float_as_uint(lsum), false, false); lsum = __uint_as_float(rr[0]) + __uint_as_float(rr[1]); }
    const float rl = 1.0f / lsum;
    LAS unsigned char* stg = F.lds + ATT_OST + wid * OST_WAVE;
#pragma unroll
    for (int d = 0; d < 4; ++d)
#pragma unroll
        for (int g = 0; g < 4; ++g) { u32x2 w; w.x = cvt_pk_bf16(o[d][4 * g] * rl, o[d][4 * g + 1] * rl); w.y = cvt_pk_bf16(o[d][4 * g + 2] * rl, o[d][4 * g + 3] * rl);
            *(LAS u32x2*)(stg + c * OST_PITCH + (32 * d + 8 * g + 4 * hi) * 2) = w; }
    asm volatile("s_waitcnt lgkmcnt(0)" ::: "memory");
    bf16_t* op = O + (size_t)(b * 16 + qb) * OSLOT_ELEMS + (size_t)(32 * wid) * DM + h * DV;
#pragma unroll
    for (int it = 0; it < 8; ++it) { const int row = 4 * it + (lane >> 4), ch = lane & 15; const u32x4 v = *(const LAS u32x4*)(stg + row * OST_PITCH + ch * 16); *(u32x4*)(op + (size_t)row * DM + ch * 8) = v; }
    asm volatile("s_waitcnt lgkmcnt(0)" ::: "memory");
}
__device__ __forceinline__ void attn_tiled(const Frame& F, const bf16_t* cq, const float* statq, const bf16_t* wqi, const bf16_t* kimg, const bf16_t* vimg, bf16_t* O, const float* g_q, const int* positions) {
    if (F.G == 256 && ATT_MAP16) {
        const int x = F.vcu >> 5, u = F.vcu & 31, g = u >> 4, qq = u & 15;
        attn_unit(F, cq, statq, wqi, kimg, vimg, O, g_q, positions, 4 * x + g, qq, false);
        attn_unit(F, cq, statq, wqi, kimg, vimg, O, g_q, positions, 4 * x + 2 + g, 15 - qq, true);
        return;
    }
    for (int i = F.vcu * 2; i < BATCH * NH * 16; i += F.G * 2)
        for (int k = 0; k < 2; ++k) { const int v = i >> 1, bh = v >> 3, s = v & 7; attn_unit(F, cq, statq, wqi, kimg, vimg, O, g_q, positions, bh, k == 0 ? 15 - s : s, ATT_DESC2 && k == 1); }
}
__device__ __forceinline__ float attn_logit_bound(const float* g_q, const float* g_k, int lane) {
    float mq = 0.f, mk = 0.f;
#pragma unroll
    for (int i = 0; i < 3; ++i) { mq = fmaxf(mq, fabsf(g_q[lane + 64 * i])); mk = fmaxf(mk, fabsf(g_k[lane + 64 * i])); }
    mq = fmaxf(mq, xshfl<1>(mq)); mq = fmaxf(mq, xshfl<2>(mq)); mq = fmaxf(mq, xshfl<4>(mq)); mq = fmaxf(mq, xshfl<8>(mq)); mq = fmaxf(mq, xshfl<16>(mq)); mq = max32(mq);
    mk = fmaxf(mk, xshfl<1>(mk)); mk = fmaxf(mk, xshfl<2>(mk)); mk = fmaxf(mk, xshfl<4>(mk)); mk = fmaxf(mk, xshfl<8>(mk)); mk = fmaxf(mk, xshfl<16>(mk)); mk = max32(mk);
    return 13.856406460551018f * 1.4426950408889634f * mq * mk;
}
template <class BarFn, class QuFn>
__device__ __forceinline__ void attn_phase(const Frame& F, bf16_t* Q, const bf16_t* cq, const float* statq, const bf16_t* wqi, const bf16_t* kimg, const bf16_t* vimg, bf16_t* O_slots, bf16_t* O, const float* g_q, const float* g_k,
                                           const int* positions, const BarFn& grid_bar, const QuFn& qu_gemm) {
    const float B = attn_logit_bound(g_q, g_k, F.lane);
    const bool tiled = __builtin_amdgcn_readfirstlane(B <= ATT_BMAX ? 1 : 0) != 0;
    if (F.tid == 0) F.MISC[24] = tiled ? 1u : 0u;
    if (tiled) attn_tiled(F, cq, statq, wqi, kimg, vimg, O_slots, g_q, positions);
    else { qu_gemm(); grid_bar(); finalize_q(F, Q, g_q, positions); grid_bar(); attn_simple(F, Q, kimg, vimg, O); }
}

struct EpiKvu {
    static constexpr bool PERM = true, AFTER_DRAIN = false;
    bf16_t* kimg; bf16_t* vimg; const float* statc; const float* statpe; const float* kpe; const float* g_k; const int* positions; LAS float* P; int tid;
    __device__ __forceinline__ void operator()(const f32x4 (&acc)[2][2][4][2], const pg8::Unit& u, int wr, int wc, int fr, int fq) const {
        const int ln = lane_now(); fr = ln & 15; fq = ln >> 4;
        const int cin = wc * 32 + 8 * fq;
        if (u.pn >= 4) {
            float rv[2][4];
#pragma unroll
            for (int ai = 0; ai < 2; ++ai)
#pragma unroll
                for (int m = 0; m < 4; ++m) rv[ai][m] = row_rinv(statc, u.pm * 256 + ai * 128 + wr * 64 + m * 16 + fr, 1.0f / KVLR);
#pragma unroll
            for (int ai = 0; ai < 2; ++ai)
#pragma unroll
                for (int m = 0; m < 4; ++m) {
                    const int row = u.pm * 256 + ai * 128 + wr * 64 + m * 16 + fr, b = row / SEQ, s = row % SEQ;
                    const float r = rv[ai][m];
#pragma unroll
                    for (int bj = 0; bj < 2; ++bj) { bf16_t* o = vimg + ((size_t)(b * NH + 2 * (u.pn - 4) + bj) * SEQ + s) * (VT_PITCH / 2) + cin; *(u32x4*)o = pack8(acc[ai][bj][m][0] * r, acc[ai][bj][m][1] * r); }
                }
            return;
        }
        float rr[2][4], pes[2][4];
        LAS float* Pw = P + (wr * 64 + fr) * 8 + wc;
#pragma unroll
        for (int ai = 0; ai < 2; ++ai)
#pragma unroll
            for (int m = 0; m < 4; ++m) {
                const int rl = ai * 128 + wr * 64 + m * 16 + fr; const float r = row_rinv(statc, u.pm * 256 + rl, 1.0f / KVLR); rr[ai][m] = r; pes[ai][m] = statpe[u.pm * 256 + rl];
                float ss[2];
#pragma unroll
                for (int bj = 0; bj < 2; ++bj) { const f32x4 a0 = acc[ai][bj][m][0] * r, a1 = acc[ai][bj][m][1] * r, q0 = a0 * a0, q1 = a1 * a1; ss[bj] = ((q0.x + q0.y) + (q0.z + q0.w)) + ((q1.x + q1.y) + (q1.z + q1.w)); }
#pragma unroll
                for (int bj = 0; bj < 2; ++bj) { ss[bj] += xshfl<16>(ss[bj]); ss[bj] = sum32(ss[bj]); }
                if (fq == 0) { Pw[(ai * 128 + m * 16) * 8] = ss[0]; Pw[(ai * 128 + m * 16) * 8 + 4] = ss[1]; }
            }
        asm volatile("s_waitcnt lgkmcnt(0)" ::: "memory"); __builtin_amdgcn_s_barrier(); asm volatile("" ::: "memory");
        __builtin_amdgcn_sched_barrier(0);
        const LAS float* Pr = P + (wr * 64 + fr) * 8;
        const f32x4 gk0 = *(const f32x4*)(g_k + cin), gk1 = *(const f32x4*)(g_k + cin + 4);
#pragma unroll
        for (int ai = 0; ai < 2; ++ai)
#pragma unroll
            for (int m = 0; m < 4; ++m) {
                const int rl = ai * 128 + wr * 64 + m * 16 + fr, row = u.pm * 256 + rl, b = row / SEQ, s = row % SEQ; const float pe = pes[ai][m];
#pragma unroll
                for (int bj = 0; bj < 2; ++bj) { const f32x4 p = *(const LAS f32x4*)(Pr + (ai * 128 + m * 16) * 8 + bj * 4);
                    const float sc = rsqrtf((((p.x + p.y) + (p.z + p.w)) + pe) * (1.0f / DQK) + EPS) * rr[ai][m];
                    bf16_t* o = kimg + ((size_t)(b * NH + 2 * u.pn + bj) * SEQ + s) * (KT_PITCH / 2) + cin; *(u32x4*)o = pack8(acc[ai][bj][m][0] * gk0 * sc, acc[ai][bj][m][1] * gk1 * sc); }
            }
        __builtin_amdgcn_sched_barrier(0);
        {
            const int tl = (wr * 4 + wc) * 64 + lane_now();
#pragma unroll 1
            for (int it = 0; it < 2; ++it) {
                const int item = tl + 512 * it, rl = item >> 2, c4 = item & 3, hfi = c4 & 1, second = c4 >> 1, row = u.pm * 256 + rl, b = row / SEQ, s = row % SEQ, pos = positions[row]; const float pe = statpe[row];
                const f32x4 pa = *(const LAS f32x4*)(P + (rl * 2 + 0) * 4), pb = *(const LAS f32x4*)(P + (rl * 2 + 1) * 4);
                const float rk0 = rsqrtf((((pa.x + pa.y) + (pa.z + pa.w)) + pe) * (1.0f / DQK) + EPS), rk1 = rsqrtf((((pb.x + pb.y) + (pb.z + pb.w)) + pe) * (1.0f / DQK) + EPS);
                const float* kp = kpe + (size_t)row * DR + 16 * hfi; const float* g1 = g_k + DN + 16 * hfi;
                bf16_t* ob0 = kimg + ((size_t)(b * NH + 2 * u.pn) * SEQ + s) * (KT_PITCH / 2) + DN + 16 * c4; bf16_t* ob1 = ob0 + (size_t)SEQ * (KT_PITCH / 2);
                f32x4 ov[4];
#pragma unroll
                for (int q4 = 0; q4 < 4; ++q4) { const f32x4 x1 = *(const f32x4*)(kp + 4 * q4) * *(const f32x4*)(g1 + 4 * q4), x2 = *(const f32x4*)(kp + 32 + 4 * q4) * *(const f32x4*)(g1 + 32 + 4 * q4);
#pragma unroll
                    for (int e = 0; e < 4; ++e) { float cs, sn; rope_cs(pos, 16 * hfi + 4 * q4 + e, cs, sn); ov[q4][e] = second ? x2[e] * cs + x1[e] * sn : x1[e] * cs - x2[e] * sn; } }
                *(u32x4*)ob0 = pack8(ov[0] * rk0, ov[1] * rk0); *(u32x4*)(ob0 + 8) = pack8(ov[2] * rk0, ov[3] * rk0);
                *(u32x4*)ob1 = pack8(ov[0] * rk1, ov[1] * rk1); *(u32x4*)(ob1 + 8) = pack8(ov[2] * rk1, ov[3] * rk1);
            }
        }
        asm volatile("s_waitcnt lgkmcnt(0)" ::: "memory");
    }
};

constexpr size_t MiB = 1u << 20;
constexpr size_t WS_CTL = 0, CTL_ZERO_BYTES = 64 * 1024;
constexpr size_t WS_SSQX = 1 * MiB, WS_SSQC = WS_SSQX + 256 * 1024, WS_SSQQ = WS_SSQC + 256 * 1024;
constexpr size_t WS_KPE = 2 * MiB;
constexpr size_t WS_WPOOL = 6 * MiB;
constexpr size_t WS_WKVQ = 7 * MiB;
constexpr size_t WS_WUKV = 9 * MiB;
constexpr size_t WS_WDQ1 = 11 * MiB;
constexpr size_t WS_WUQ = 11 * MiB + 512 * 1024;
constexpr size_t WS_WO = 13 * MiB;
constexpr size_t WS_WGU = 17 * MiB;
constexpr size_t WS_WD = 28 * MiB;
constexpr size_t WS_SSQPE = WS_SSQQ + 256 * 1024;
constexpr size_t WS_XB = 34 * MiB;
constexpr size_t WS_VT = 66 * MiB;
constexpr size_t WS_KF = 106 * MiB;
constexpr size_t WS_R = 156 * MiB;
constexpr size_t WS_WQI = 244 * MiB;
constexpr size_t WS_SSQX2 = 246 * MiB;
constexpr size_t WS_CQB = 247 * MiB;
constexpr size_t WS_END = 255 * MiB;
constexpr int CW_BAR = 4096;

constexpr int PT_OFF = MISC_OFF + 128;
static_assert(PT_OFF + 24 * 8 <= LDS_BYTES, "pointer table");
template <class T, int K> __device__ __forceinline__ T* ldptr(const LAS unsigned long long*) {
    unsigned a; asm volatile("v_mov_b32 %0, %1" : "=v"(a) : "n"(PT_OFF + 8 * K));
    const unsigned long long v = *(const LAS unsigned long long*)(size_t)a;
    const unsigned lo = __builtin_amdgcn_readfirstlane((unsigned)v), hi = __builtin_amdgcn_readfirstlane((unsigned)(v >> 32));
    GAS T* g = (GAS T*)(((unsigned long long)hi << 32) | lo);
    return (T*)g;
}
#define XB_TMO      128
#define XB_XCNT(j)  (256  + 64 * (j))
#define XB_XSUB(j)  (1280 + 64 * (j))
#define XB_XGEN(j)  (2304 + 64 * (j))
#define XB_TOP      3328
#define XB_TOPGEN   3392
#define XB_XT       3520
#define XB_DONE1    3840
#define XB_DONE2    3904
#define XB_GB       4096
#define XCD_BAR_WORDS 8192
#define XB_SPIN_CAP (1u << 18)
__device__ __forceinline__ unsigned xb_ld(unsigned* p)              { return __hip_atomic_load(p, __ATOMIC_RELAXED, __HIP_MEMORY_SCOPE_AGENT); }
__device__ __forceinline__ unsigned xb_add(unsigned* p, unsigned v) { return __hip_atomic_fetch_add(p, v, __ATOMIC_RELAXED, __HIP_MEMORY_SCOPE_AGENT); }
__device__ __forceinline__ unsigned xb_xcc_id() { return (unsigned)__builtin_amdgcn_s_getreg((3 << 11) | 20) & 0xFu; }
#define XB_SPIN(cond, bar) do { unsigned _sp = 0; while (cond) { __builtin_amdgcn_s_sleep(1); \
    if ((++_sp & 255u) == 0u) { if (xb_ld(&(bar)[XB_TMO])) break; if (_sp > XB_SPIN_CAP) { atomicAdd(&(bar)[XB_TMO], 1u); break; } } } } while (0)
struct XcdBarrier { const LAS unsigned long long* PT; volatile LAS unsigned* st; int wave; };
__device__ __forceinline__ unsigned* xb_words(const LAS unsigned long long* PT) { return (unsigned*)(ldptr<unsigned char, 23>(PT) + WS_CTL) + CW_BAR; }
__device__ __forceinline__ bool xb_leader(int wave) { unsigned lane; asm volatile("v_mbcnt_lo_u32_b32 %0, -1, 0\n\tv_mbcnt_hi_u32_b32 %0, -1, %0" : "=v"(lane)); return wave == 0 && lane == 0; }
__device__ __forceinline__ void xcd_barrier_post(const XcdBarrier& b) {
    if (xb_leader(b.wave)) { unsigned* bar = xb_words(b.PT); const unsigned x = xb_xcc_id();
        if (gridDim.x == 256) (void)xb_add(&bar[XB_XT + blockIdx.x], x + 1u);
        (void)xb_add(&bar[XB_XCNT(x)], 1u); }
}
__device__ __forceinline__ void xcd_barrier_complete(unsigned* bar, unsigned x, unsigned& nloc, unsigned& nx) {
    const unsigned G = gridDim.x * gridDim.y * gridDim.z;
    unsigned sum, cnt, mine, sp = 0u;
    for (;;) {
        sum = 0u; cnt = 0u; mine = 0u;
#pragma unroll
        for (unsigned j = 0; j < 16; ++j) { const unsigned c = xb_ld(&bar[XB_XCNT(j)]); sum += c; cnt += (c > 0u) ? 1u : 0u; mine = (j == x) ? c : mine; }
        if (sum == G) break;
        __builtin_amdgcn_s_sleep(1);
        if ((++sp & 255u) == 0u) { if (xb_ld(&bar[XB_TMO])) break; if (sp > XB_SPIN_CAP) { atomicAdd(&bar[XB_TMO], 1u); break; } }
    }
    nloc = mine > 0u ? mine : 1u; nx = cnt > 0u ? cnt : 1u;
}
__device__ __forceinline__ unsigned xcd_group_colocated(unsigned* bar, unsigned x) {
    if (gridDim.x != 256) return 0u;
    unsigned ok = 1u;
    for (unsigned k = 0; k < 4; ++k) {
        unsigned v = 0u, sp = 0u;
        while ((v = xb_ld(&bar[XB_XT + (blockIdx.x & 63u) + 64u * k])) == 0u) { __builtin_amdgcn_s_sleep(1); if (++sp > XB_SPIN_CAP) { ok = 0u; break; } }
        if (v != x + 1u) ok = 0u;
    }
    return ok;
}
__device__ __forceinline__ void xcd_barrier(const XcdBarrier& b, bool light = false) {
    asm volatile("s_waitcnt vmcnt(0)" ::: "memory");
    __syncthreads();
    if (xb_leader(b.wave)) {
        unsigned* bar = xb_words(b.PT); const unsigned x = xb_xcc_id();
        __builtin_amdgcn_s_waitcnt(0);
        unsigned nloc = b.st[0], nx = b.st[1];
        if (nloc == 0u) { xcd_barrier_complete(bar, x, nloc, nx); b.st[0] = nloc; b.st[1] = nx; b.st[2] = xcd_group_colocated(bar, x); }
        const bool skip_wb = light && b.st[2] != 0u;
        if (light && !skip_wb) { __builtin_amdgcn_fence(__ATOMIC_RELEASE, "agent"); asm volatile("s_waitcnt vmcnt(0)" ::: "memory"); }
        const unsigned old = xb_add(&bar[XB_XSUB(x)], 1u);
        const unsigned gen = old / nloc;
        if (old + 1u == (gen + 1u) * nloc) {
            if (!light) { __builtin_amdgcn_fence(__ATOMIC_RELEASE, "agent"); }
            asm volatile("s_waitcnt vmcnt(0)" ::: "memory");
            const unsigned og = xb_add(&bar[XB_TOP], 1u);
            const unsigned tg = og / nx;
            if (og + 1u == (tg + 1u) * nx) xb_add(&bar[XB_TOPGEN], 1u);
            else XB_SPIN(xb_ld(&bar[XB_TOPGEN]) == tg, bar);
            __builtin_amdgcn_fence(__ATOMIC_ACQUIRE, "agent");
            xb_add(&bar[XB_XGEN(x)], 1u);
            asm volatile("s_waitcnt vmcnt(0)" ::: "memory");
        } else {
            XB_SPIN(xb_ld(&bar[XB_XGEN(x)]) == gen, bar);
            __builtin_amdgcn_fence(__ATOMIC_ACQUIRE, "agent");
            asm volatile("s_waitcnt vmcnt(0)" ::: "memory");
        }
    }
    __syncthreads();
}

__device__ __forceinline__ bool grid_is_256() { unsigned g = gridDim.x; asm volatile("" : "+s"(g)); return g == 256u; }
__device__ __forceinline__ void group_barrier(const XcdBarrier& b, int done_word = -1) {
    if (!grid_is_256()) { xcd_barrier(b, true); return; }
    asm volatile("s_waitcnt vmcnt(0)" ::: "memory");
    __syncthreads();
    if (xb_leader(b.wave)) {
        unsigned* bar = xb_words(b.PT);
        __builtin_amdgcn_s_waitcnt(0);
        if (done_word >= 0) (void)xb_add(&bar[done_word], 1u);
        if (b.st[2] == 0u) { __builtin_amdgcn_fence(__ATOMIC_RELEASE, "agent"); asm volatile("s_waitcnt vmcnt(0)" ::: "memory"); }
        const unsigned use = b.st[3]; b.st[3] = use + 1u;
        unsigned* gc = &bar[XB_GB + 64u * (blockIdx.x & 63u)];
        (void)xb_add(gc, 1u);
        XB_SPIN(xb_ld(gc) < 4u * (use + 1u), bar);
        __builtin_amdgcn_fence(__ATOMIC_ACQUIRE, "agent");
        asm volatile("s_waitcnt vmcnt(0)" ::: "memory");
    }
    __syncthreads();
}

__device__ __forceinline__ void all_done_wait(const XcdBarrier& b, int done_word) {
    if (!grid_is_256() || !GROUP_SEAMS) return;
    if (xb_leader(b.wave)) { unsigned* bar = xb_words(b.PT); XB_SPIN(xb_ld(&bar[done_word]) < 256u, bar); }
    __syncthreads();
}

#ifndef ATTN_MODE
#define ATTN_MODE 1
#endif
#ifndef ONE_LAUNCH
#define ONE_LAUNCH 1
#endif
constexpr int NPH = 18;
struct Args { const void* in[22]; float* out; unsigned char* ws; int lo, hi; };

constexpr int RTAB_OFF = STATP_OFF + 8192;
static_assert(RTAB_OFF + 1024 <= MISC_OFF, "LDS map");
__device__ __forceinline__ int prep_rtab(const Frame& F, const pg8::Gemm g, const float* stat, float invn) {
    pg8::StaticOrder S; S.init(g.M, g.N, F.G, (int)blockIdx.x); pg8::Unit u; int pm = -1;
    if (S.next(0, u)) { pm = u.pm; if (F.tid < 256) ((LAS float*)(F.lds + RTAB_OFF))[F.tid] = row_rinv(stat, u.pm * 256 + F.tid, invn); }
    asm volatile("s_waitcnt lgkmcnt(0)" ::: "memory"); __syncthreads();
    return pm;
}
#define RTAB_PTR ((const LAS float*)(F.lds + RTAB_OFF))
struct RtabHook {
    f32x4 p; float invn; LAS float* rt; int tid; bool on;
    __device__ __forceinline__ void operator()() const {
        if (on && tid < 256) rt[tid] = rsqrtf(((p.x + p.y) + (p.z + p.w)) * invn + EPS);
        asm volatile("s_waitcnt lgkmcnt(0)" ::: "memory");
    }
};
__device__ __forceinline__ RtabHook rtab_issue(const Frame& F, const pg8::Gemm g, const float* stat, float invn, int& pm) {
    pg8::StaticOrder S; S.init(g.M, g.N, F.G, (int)blockIdx.x); pg8::Unit u; pm = -1;
    RtabHook h{(f32x4){1.f, 0.f, 0.f, 0.f}, invn, (LAS float*)(F.lds + RTAB_OFF), F.tid, false};
    if (S.next(0, u)) { pm = u.pm; h.on = true; if (F.tid < 256) h.p = *(const f32x4*)(stat + 4 * (size_t)(u.pm * 256 + F.tid)); }
    return h;
}
template <class Q, class Hook = pg8::NoHook> __device__ __forceinline__ void run_gemm(const Frame& F, const pg8::Gemm g, const Q& q, const Hook& hook = Hook()) {
    pg8::StaticOrder S; S.init(g.M, g.N, F.G, (int)blockIdx.x);
    const pg8::EpiQuad<Q> E{q};
    pg8::gemm_phase<pg8::EpiQuad<Q>, pg8::StaticOrder, true, true, Hook>(F.lds, g, S, E, F.tid, hook);
}
template <class Q, class Hook = pg8::NoHook> __device__ __forceinline__ void run_gemm_stat(const Frame& F, const pg8::Gemm g, const Q& q, const Hook& hook = Hook()) {
    pg8::StaticOrder S; S.init(g.M, g.N, F.G, (int)blockIdx.x);
    const pg8::EpiQuadStat<Q> E{q, (LAS float*)(F.lds + STATP_OFF), F.tid};
    pg8::gemm_phase<pg8::EpiQuadStat<Q>, pg8::StaticOrder, true, true, Hook>(F.lds, g, S, E, F.tid, hook);
}

__global__ void __launch_bounds__(NWAVES * 64, 2) mk_fwd(Args args) {
    extern __shared__ __attribute__((aligned(16))) unsigned char lds_raw[];
    Frame F0;
    F0.lds = (LAS unsigned char*)lds_raw; F0.MISC = (volatile LAS unsigned*)(F0.lds + MISC_OFF);
    F0.tid = threadIdx.x; F0.lane = F0.tid & 63; F0.wave = __builtin_amdgcn_readfirstlane(F0.tid >> 6);
    F0.G = gridDim.x; { const int bx = blockIdx.x; F0.vcu = (F0.G % 8 == 0) ? (bx % 8) * (F0.G / 8) + bx / 8 : bx; }
    F0.gw = F0.vcu * NWAVES + F0.wave; F0.ngw = F0.G * NWAVES;
    for (int u = F0.tid; u < (LDS_BYTES - RING_BYTES) / 4; u += NWAVES * 64) ((LAS unsigned*)(F0.lds + RING_BYTES))[u] = 0u;
    __syncthreads();
    LAS unsigned long long* PTw = (LAS unsigned long long*)(F0.lds + PT_OFF);
    if (F0.tid == 0) {
#define PT_SET(k) PTw[k] = (unsigned long long)args.in[k]
        PT_SET(0); PT_SET(1); PT_SET(2); PT_SET(3); PT_SET(4); PT_SET(5); PT_SET(6); PT_SET(7); PT_SET(8); PT_SET(9); PT_SET(10); PT_SET(11);
        PT_SET(12); PT_SET(13); PT_SET(14); PT_SET(15); PT_SET(16); PT_SET(17); PT_SET(18); PT_SET(19); PT_SET(20); PT_SET(21);
#undef PT_SET
        PTw[22] = (unsigned long long)args.out; PTw[23] = (unsigned long long)args.ws;
    }
    __syncthreads();
    const LAS unsigned long long* PT = (const LAS unsigned long long*)(F0.lds + PT_OFF);
    const XcdBarrier bar{PT, F0.MISC + 8, F0.wave};
#if ONE_LAUNCH
    xcd_barrier_post(bar);
#endif
#define IN_F(k) ldptr<const float, k>(PT)
#define X_IN IN_F(0)
#define POSITIONS ldptr<const int, 1>(PT)
#define LN_MIX_A IN_F(2)
#define W_POOL IN_F(3)
#define B_POOL IN_F(4)
#define POOL_SCALE IN_F(5)
#define LN_FFN IN_F(6)
#define W_GATE IN_F(7)
#define W_UP IN_F(8)
#define W_DOWN IN_F(9)
#define LN_KV IN_F(10)
#define W_DKV IN_F(11)
#define G_KV_LATENT IN_F(12)
#define W_UK IN_F(13)
#define W_UV IN_F(14)
#define G_K IN_F(15)
#define LN_MIX_B IN_F(16)
#define W_DQ IN_F(17)
#define G_Q_LATENT IN_F(18)
#define W_UQ IN_F(19)
#define G_Q IN_F(20)
#define W_O IN_F(21)
#define XO ldptr<float, 22>(PT)
#define WSB(T, off) ((T*)(ldptr<unsigned char, 23>(PT) + (off)))
#define SSQX WSB(float, WS_SSQX)
#define SSQC WSB(float, WS_SSQC)
#define SSQQ WSB(float, WS_SSQQ)
#define SSQPE WSB(float, WS_SSQPE)
#define KPE WSB(float, WS_KPE)
#define WPOOL_T WSB(bf16_t, WS_WPOOL)
#define WKVQ_T WSB(bf16_t, WS_WKVQ)
#define WUKV_T WSB(bf16_t, WS_WUKV)
#define WDQ1_T WSB(bf16_t, WS_WDQ1)
#define WUQ_T WSB(bf16_t, WS_WUQ)
#define WO_T WSB(bf16_t, WS_WO)
#define WGU_T WSB(bf16_t, WS_WGU)
#define WD_T WSB(bf16_t, WS_WD)
#define XB WSB(bf16_t, WS_XB)
#define VT WSB(bf16_t, WS_VT)
#define KFIN WSB(bf16_t, WS_KF)
#define WQI WSB(bf16_t, WS_WQI)
#define SSQX2 WSB(float, WS_SSQX2)
#define SSQIN WSB(float, WS_SSQX2 + 256 * 1024)
#define SSQ3 WSB(float, WS_SSQX2 + 512 * 1024)
#define XB2 WSB(bf16_t, WS_KF + 17 * MiB)
#define HID WSB(bf16_t, WS_R)
#define DPOOL WSB(bf16_t, WS_VT)
#define QB_ WSB(bf16_t, WS_R)
#define CKVB (WSB(bf16_t, WS_R) + CKV_OFF)
#define OB_ WSB(bf16_t, WS_R + 48 * MiB)
#define CQB WSB(bf16_t, WS_CQB)

    const int lo = args.lo, hi = args.hi; int ph = 0;
#if ONE_LAUNCH
#define PH_COND true
#define PH_BAR_COND true
#else
#define PH_COND (ph >= lo && ph < hi)
#define PH_BAR_COND (ph + 1 < hi)
#endif
#define PH_BEGIN if (PH_COND) { Frame F = F0; asm volatile("v_mbcnt_lo_u32_b32 %0, -1, 0\n\tv_mbcnt_hi_u32_b32 %0, -1, %0" : "=v"(F.lane) :: "memory"); asm volatile("" : "+s"(F.G), "+s"(F.gw), "+s"(F.ngw), "+s"(F.vcu), "+s"(F.wave)); F.tid = F.wave * 64 + F.lane;
#define PH_END   if (PH_BAR_COND) xcd_barrier(bar); } ++ph;
#define PH_END_L if (PH_BAR_COND) xcd_barrier(bar, LIGHT_SEAMS); } ++ph;
#define WGU_L(l) WSB(bf16_t, (l) == 1 ? WS_KF : WS_WGU)
#define WD_L(l) WSB(bf16_t, (l) == 1 ? WS_KF + 11 * MiB : WS_WD)
#define PREP_FFN(l) do { int rot_ = 0; PREP_FFN_R(l); } while (0)
#define PREP_FFN_R(l) prep_ffn(F, rot_, W_GATE + (size_t)(l) * DM * DFF, W_UP + (size_t)(l) * DM * DFF, W_DOWN + (size_t)(l) * DFF * DM, LN_FFN + (l) * DM, WGU_L(l), WD_L(l))
#define PREP_W0_R() do { \
        for (int g = 0; g < 4; ++g) prep_mat(F, rot_, W_POOL + (size_t)(4 + g) * 65536, 256, 256, 256, 0, nullptr, WPOOL_T + (size_t)1024 * 256, RM_PLAIN, 256 * g); \
        prep_mat(F, rot_, W_DKV, 576, DM, 512, 0, LN_KV, WKVQ_T, RM_PLAIN, 0); \
        prep_mat(F, rot_, W_DQ, QLR, DM, QLR, 0, LN_MIX_B, WKVQ_T, RM_PLAIN, 512); \
        prep_mat(F, rot_, W_DKV, 576, DM, DR, 512, LN_KV, WKVQ_T, RM_PLAIN, 768); \
        prep_mat(F, rot_, W_UK, DM, KVLR, DM, 0, G_KV_LATENT, WUKV_T, RM_PLAIN, 0); \
        prep_mat(F, rot_, W_UV, DM, KVLR, DM, 0, G_KV_LATENT, WUKV_T, RM_PLAIN, 1024); \
        for (int j = 0; j < 2; ++j) prep_mat(F, rot_, W_UQ + (size_t)j * QLR * 1536, 1536, QLR, 1536, 0, G_Q_LATENT + j * QLR, WUQ_T + (size_t)j * 1536 * QLR, RM_PLAIN, 0); } while (0)
#define PREP_W1_R() do { \
        prep_mat(F, rot_, W_DQ + (size_t)DM * QLR, QLR, DM, QLR, 0, LN_MIX_B + DM, WDQ1_T, RM_PLAIN, 0); \
        for (int j = 0; j < 2; ++j) prep_mat(F, rot_, W_O + (size_t)j * DM * DM, DM, DM, DM, 0, nullptr, WO_T + (size_t)j * DM * DM, RM_PLAIN, 0); } while (0)
#define early_prep grid_is_256()

    PH_BEGIN
        int rot_ = 0;
        for (int g = 0; g < 4; ++g) prep_mat(F, rot_, W_POOL + (size_t)g * 65536, 256, 256, 256, 0, nullptr, WPOOL_T, RM_PLAIN, 256 * g);
        if (!early_prep) { PREP_W0_R(); PREP_W1_R(); }
        { bf16_t* wk = WKVQ_T; for (int i = F.vcu * 512 + F.tid; i < 192 * 1024 / 8; i += F.G * 512) *(u32x4*)(wk + (size_t)832 * 1024 + 8 * (size_t)i) = (u32x4){0u, 0u, 0u, 0u}; }
        PREP_FFN_R(0);
        rowstat_x(F, X_IN, SSQIN);
    PH_END

    for (int l = 0; l < 4; ++l) {
        if (l < 2) {
            PH_BEGIN { if (l > 0 && !early_prep) PREP_FFN(l);
                       if (l == 1) prep_wqimg(F, WUQ_T, WQI);
                       const pg8::Gemm g{DPOOL, WPOOL_T + (size_t)l * 1024 * 256, M, DM, 256, DM, 256, 256};
                       { pg8::StaticOrder S; S.init(g.M, g.N, F.G, (int)blockIdx.x); pg8::Unit u; const float* st = l == 0 ? SSQIN : SSQ3; const float* ga = LN_MIX_A + l * DM; bf16_t* dp = DPOOL;
                         if (l == 0) { const float* xs = X_IN; for (int i = 0; S.next(i, u); ++i) pool_prep_unit(F, xs, st, ga, dp, u.pm, u.pn); }
                         else { const bf16_t* xs = XB2; for (int i = 0; S.next(i, u); ++i) pool_prep_unit(F, xs, st, ga, dp, u.pm, u.pn); } }
                       asm volatile("s_waitcnt vmcnt(0)" ::: "memory"); __syncthreads();
                       const QResidual q{l == 0 ? X_IN : (const float*)nullptr, nullptr, XB, B_POOL + l * DM, POOL_SCALE + l * DM, SSQX2  , l == 0 ? (const bf16_t*)nullptr : (const bf16_t*)XB2}; run_gemm_stat(F, g, q); } if (PH_BAR_COND) { if (GROUP_SEAMS) group_barrier(bar); else xcd_barrier(bar, LIGHT_SEAMS); } } ++ph;
        } else {
            const int j = l - 2;
            if (j == 1) {
                PH_BEGIN { const int nun = (M / 256) * (QLR / 256);
                           if ((int)blockIdx.x >= nun || F.G <= nun) { Frame Fp = F; if (F.G > nun) { Fp.gw = ((int)blockIdx.x - nun) * NWAVES + F.wave; Fp.ngw = (F.G - nun) * NWAVES; }
                               all_done_wait(bar, XB_DONE2);
                               { const Frame& F = Fp; PREP_FFN(l); } __syncthreads(); }
                           const pg8::Gemm g{XB, WDQ1_T, M, QLR, DM, DM, DM, 0}; const float* st_ = SSQX; int tpm_; const RtabHook hk_ = rtab_issue(F, g, st_, 1.0f / DM, tpm_); const QRowScale q{CQB, QLR, st_, 1.0f / DM, SSQQ, RTAB_PTR, tpm_}; run_gemm_stat(F, g, q, hk_); } PH_END
            }
            PH_BEGIN attn_phase(F, QB_, CQB, SSQQ, WQI + (size_t)j * NH * (WQI_HEAD / 2), KFIN, VT, WSB(bf16_t, WS_R), OB_, G_Q + j * DQK, G_K, POSITIONS, [&]() { xcd_barrier(bar); },
                                [&]() { const pg8::Gemm g{CQB, WUQ_T + (size_t)j * 1536 * QLR, M, 1536, QLR, QLR, QLR, 0}; const float* st_ = SSQQ; const int tpm_ = prep_rtab(F, g, st_, 1.0f / QLR);
                                        const QRowScale q{QB_, 1536, st_, 1.0f / QLR, nullptr, RTAB_PTR, tpm_}; run_gemm(F, g, q); }); PH_END
            PH_BEGIN { const bool slots_ = F.MISC[24] != 0u;
                       const pg8::Gemm g{slots_ ? WSB(bf16_t, WS_R) : OB_, WO_T + (size_t)j * DM * DM, M, DM, DM, DM, DM, 0, slots_ ? OSLOT_ELEMS * 2 : (size_t)0}; const QResidual q{nullptr, nullptr, XB, nullptr, nullptr, SSQX}; run_gemm_stat(F, g, q);
                       if (PH_BAR_COND) { if (GROUP_SEAMS && slots_) group_barrier(bar); else xcd_barrier(bar, LIGHT_SEAMS); } } } ++ph;
        }
        PH_BEGIN { const pg8::Gemm g{XB, WGU_L(l), M, NGU, DM, DM, DM, 0}; const float* st_ = l < 2 ? SSQX2 : SSQX; int tpm_; const RtabHook hk_ = rtab_issue(F, g, st_, 1.0f / DM, tpm_); const QGateUp q{HID, st_, RTAB_PTR, tpm_}; run_gemm(F, g, q, hk_);
                   if (early_prep && l < 2 && (int)blockIdx.x >= 128) {
                       Frame Fp = F; Fp.gw = ((int)blockIdx.x - 128) * NWAVES + F.wave; Fp.ngw = 128 * NWAVES;
                       { const Frame& F = Fp; int rot_ = 0; PREP_FFN_R(l + 1); if (l == 0) PREP_W0_R(); else PREP_W1_R(); } } } if (PH_BAR_COND) { if (GROUP_SEAMS) group_barrier(bar); else xcd_barrier(bar, LIGHT_SEAMS); } } ++ph;
        PH_BEGIN { const pg8::Gemm g{HID, WD_L(l), M, DM, DFF, DFF, DFF, 0}; const QResidual q{nullptr, l == 3 ? XO : (float*)nullptr, l == 0 ? XB2 : XB, nullptr, nullptr, l == 0 ? SSQ3 : SSQX, l == 0 ? (const bf16_t*)XB : (const bf16_t*)nullptr}; run_gemm_stat(F, g, q); } if (PH_BAR_COND && l < 3) { if (GROUP_SEAMS && l >= 1) group_barrier(bar, l == 1 ? XB_DONE1 : XB_DONE2); else xcd_barrier(bar, LIGHT_SEAMS && (l == 1 || l == 2)); } } ++ph;
        if (l == 1) {
            PH_BEGIN { if (!early_prep) { PREP_FFN(2); __syncthreads(); } const pg8::Gemm g{XB, WKVQ_T, M, DM, DM, DM, DM, 0}; const float* st_ = SSQX; int tpm_; const RtabHook hk_ = rtab_issue(F, g, st_, 1.0f / DM, tpm_); const QKvd q{CKVB, CQB, KPE, st_, SSQC, SSQQ, SSQPE, RTAB_PTR, tpm_}; run_gemm_stat(F, g, q, hk_); } if (PH_BAR_COND) { if (GROUP_SEAMS) group_barrier(bar); else xcd_barrier(bar, LIGHT_SEAMS); } } ++ph;
            PH_BEGIN { all_done_wait(bar, XB_DONE1);
                       const pg8::Gemm g{CKVB, WUKV_T, M, 2048, KVLR, KVLR, KVLR, 0, CKV_TSTEP * 2}; pg8::StaticOrder S; S.init(g.M, g.N, F.G, (int)blockIdx.x);
                       const EpiKvu E{KFIN, VT, SSQC, SSQPE, KPE, G_K, POSITIONS, (LAS float*)(F.lds + STATP_OFF), F.tid};
                       pg8::gemm_phase<EpiKvu, pg8::StaticOrder, true, true>(F.lds, g, S, E, F.tid); } PH_END
        }
    }
#undef PH_BEGIN
#undef PH_END
#undef PH_END_L
#undef PREP_FFN
#undef PREP_FFN_R
#undef early_prep
}

extern "C" void kernel_launch(void* const* d_in, const int* in_sizes, int n_in, void* d_out, int out_size, void* d_ws, size_t ws_size, hipStream_t stream) {
    static int grid = 0;
    if (grid == 0) {
        if (n_in != 22 || in_sizes[0] != M * DM || out_size != M * DM || ws_size < WS_END) { fprintf(stderr, "kernel_launch: unexpected shapes (n_in %d, in0 %d, out %d, ws %zu)\n", n_in, n_in > 0 ? in_sizes[0] : -1, out_size, ws_size); grid = -1; return; }
        int dev = 0, cus = 0, per_cu = 0;
        if (hipGetDevice(&dev) != hipSuccess || hipDeviceGetAttribute(&cus, hipDeviceAttributeMultiprocessorCount, dev) != hipSuccess) { grid = -1; return; }
        if (hipFuncSetAttribute((const void*)mk_fwd, hipFuncAttributeMaxDynamicSharedMemorySize, LDS_BYTES) != hipSuccess) { fprintf(stderr, "kernel_launch: hipFuncSetAttribute failed\n"); grid = -1; return; }
        if (hipOccupancyMaxActiveBlocksPerMultiprocessor(&per_cu, (const void*)mk_fwd, NWAVES * 64, LDS_BYTES) != hipSuccess || per_cu < 1) { fprintf(stderr, "kernel_launch: occupancy query reports %d blocks per CU\n", per_cu); grid = -1; (void)hipGetLastError(); return; }
        grid = cus;
    }
    if (grid < 0) return;
    if (hipMemsetAsync((char*)d_ws + WS_CTL, 0, CTL_ZERO_BYTES, stream) != hipSuccess) return;
    Args a{};
    for (int i = 0; i < 22; ++i) a.in[i] = d_in[i];
    a.out = (float*)d_out; a.ws = (unsigned char*)d_ws;
#if ONE_LAUNCH
    a.lo = 0; a.hi = 1000;
    hipLaunchKernelGGL(mk_fwd, dim3(grid), dim3(NWAVES * 64), LDS_BYTES, stream, a);
#else
    for (int p = 0; p < NPH; ++p) { a.lo = p; a.hi = p + 1; hipLaunchKernelGGL(mk_fwd, dim3(grid), dim3(NWAVES * 64), LDS_BYTES, stream, a); }
#endif
}
```
